# Optimizing an MI355X kernel written in HIP

```python
import jax, jax.numpy as jnp
from jax import lax
import numpy as np

D_MODEL = 1024
BATCH = 4
SEQ = 4096
DEPTH = 2
DEC_BATCH = 32
DEC_SEQ = 64
PAST_LEN = 2048

CHUNK = 64
RWKV_HEADS = 8
RWKV_HD = 64
RWKV_W = RWKV_HEADS * RWKV_HD
DECAY_LORA = 64
AAA_LORA = 64
GATE_LORA = 128
RWKV_SIZES = (RWKV_W, RWKV_W, RWKV_W, DECAY_LORA, AAA_LORA, GATE_LORA)
RWKV_COLS = 3 * RWKV_W + DECAY_LORA + AAA_LORA + GATE_LORA
GN_EPS = 64e-5
SWA_HEADS = 8
SWA_KV_HEADS = 2
SWA_GROUP = SWA_HEADS // SWA_KV_HEADS
SWA_HD = 64
WINDOW = 128
BAND_CHUNKS = WINDOW // CHUNK
MEM_TOKENS = 256
MEM_HEADS = 4
MEM_HD = 128
MEM_W = MEM_HEADS * MEM_HD
N_BRANCH = 3
BR_W = 512
IN_SIZES = (RWKV_COLS, SWA_HEADS * SWA_HD, SWA_KV_HEADS * SWA_HD, SWA_KV_HEADS * SWA_HD, MEM_W, N_BRANCH * D_MODEL)
IN_COLS = RWKV_COLS + SWA_HEADS * SWA_HD + 2 * SWA_KV_HEADS * SWA_HD + MEM_W + N_BRANCH * D_MODEL
D_FF = 2816
CONV_W = 3
RMS_EPS = 1e-6

kernel_name = 'hybrid_rwkv7_swa_sink_mem_convffn_step'


def _split_points(sizes):
    pts, acc = [], 0
    for s in sizes[:-1]:
        acc += s
        pts.append(acc)
    return pts


def _rms(x, g):
    xf = x.astype(jnp.float32)
    y = xf * lax.rsqrt(jnp.mean(xf * xf, axis=-1, keepdims=True) + RMS_EPS)
    return (y * g.astype(jnp.float32)).astype(x.dtype)


def _rwkv(p, shift_in, s0, mu, w0, w2, a0, a2, g2, k_k, k_a, r_k, ln_g, ln_b):
    B, T = p.shape[0], p.shape[1]
    p_pad = jnp.concatenate([shift_in.astype(p.dtype), p], axis=1)
    pm = p + (p_pad[:, :-1] - p) * mu
    r, k, v, xw, xa, xg = jnp.split(pm, _split_points(RWKV_SIZES), axis=-1)
    w = -jax.nn.softplus(-(w0 + jnp.tanh(xw) @ w2)) - 0.5
    decay = jnp.exp(-jnp.exp(w.astype(jnp.float32)))
    a = jax.nn.sigmoid(a0 + xa @ a2)
    g = jax.nn.sigmoid(xg) @ g2
    hs = lambda z: z.reshape(B, T, RWKV_HEADS, RWKV_HD).astype(jnp.float32)
    kk = hs(k * k_k)
    kk = kk / jnp.maximum(jnp.sqrt(jnp.sum(kk * kk, axis=-1, keepdims=True)), 1e-12)
    k = k * (1.0 + (a - 1.0) * k_a)
    rh, kh, vh, ah, wh = hs(r), hs(k), hs(v), hs(a), hs(decay)
    tm = lambda z: jnp.moveaxis(z, 1, 0)

    def step(S, inp):
        r_t, w_t, k_t, v_t, kk_t, a_t = inp
        sa = jnp.einsum('bhvk,bhk->bhv', S, -kk_t)
        S = S * w_t[:, :, None, :] + sa[..., None] * (kk_t * a_t)[:, :, None, :] + v_t[..., None] * k_t[:, :, None, :]
        return S, jnp.einsum('bhvk,bhk->bhv', S, r_t)

    s_fin, o = lax.scan(step, s0.astype(jnp.float32), (tm(rh), tm(wh), tm(kh), tm(vh), tm(kk), tm(ah)))
    o = jnp.moveaxis(o, 0, 1)
    mean = jnp.mean(o, axis=-1, keepdims=True)
    var = jnp.mean(jnp.square(o - mean), axis=-1, keepdims=True)
    o = ((o - mean) * lax.rsqrt(var + GN_EPS)).reshape(B, T, RWKV_W) * ln_g.astype(jnp.float32) + ln_b.astype(jnp.float32)
    bonus = jnp.sum(rh * kh * r_k.astype(jnp.float32), axis=-1, keepdims=True) * vh
    o = (o + bonus.reshape(B, T, RWKV_W)) * g.astype(jnp.float32)
    return o.astype(p.dtype), s_fin.astype(s0.dtype), p_pad[:, -1:]


def _attend_sink(q, k, v, dist, valid, sink):
    s = jnp.einsum('bcqhgd,bckhd->bchgqk', q, k).astype(jnp.float32) * (SWA_HD ** -0.5)
    slopes = jnp.exp2(-8.0 * jnp.arange(1, SWA_HEADS + 1, dtype=jnp.float32) / SWA_HEADS)
    s = s - slopes.reshape(SWA_KV_HEADS, SWA_GROUP, 1, 1) * dist
    if valid is not None:
        s = jnp.where(valid[None, :, None, None, None, :], s, -jnp.inf)
    sink_l = jnp.broadcast_to(sink.astype(jnp.float32).reshape(1, 1, SWA_KV_HEADS, SWA_GROUP, 1, 1), s.shape[:-1] + (1,))
    pr = jax.nn.softmax(jnp.concatenate([s, sink_l], axis=-1), axis=-1)[..., :-1]
    return jnp.einsum('bchgqk,bckhd->bcqhgd', pr.astype(v.dtype), v)


def _swa_prompt(q, k, v, sink):
    B, T = q.shape[0], q.shape[1]
    NC = T // CHUNK
    qc = q.reshape(B, NC, CHUNK, SWA_KV_HEADS, SWA_GROUP, SWA_HD)

    def band(z):
        zc = z.reshape(B, NC, CHUNK, SWA_KV_HEADS, SWA_HD)
        zp = jnp.pad(zc, ((0, 0), (BAND_CHUNKS, 0), (0, 0), (0, 0), (0, 0)))
        return jnp.concatenate([zp[:, i:i + NC] for i in range(BAND_CHUNKS + 1)], axis=2)

    KB = (BAND_CHUNKS + 1) * CHUNK
    qi = jnp.arange(CHUNK)
    kj = jnp.arange(KB)
    dist = jnp.abs(BAND_CHUNKS * CHUNK + qi[:, None] - kj[None, :]).astype(jnp.float32)
    valid = (jnp.arange(NC)[:, None] - BAND_CHUNKS + kj[None, :] // CHUNK) >= 0
    o = _attend_sink(qc, band(k), band(v), dist, valid, sink)
    return o.reshape(B, T, SWA_HEADS * SWA_HD)


def _swa_sample(q, k, v, k_cache, v_cache, sink):
    B, T = q.shape[0], q.shape[1]
    L = k_cache.shape[1]
    kf = jnp.concatenate([k_cache.astype(k.dtype), k], axis=1)
    vf = jnp.concatenate([v_cache.astype(v.dtype), v], axis=1)
    dist = jnp.abs(L + jnp.arange(T)[:, None] - jnp.arange(L + T)[None, :]).astype(jnp.float32)
    o = _attend_sink(q.reshape(B, 1, T, SWA_KV_HEADS, SWA_GROUP, SWA_HD), kf[:, None], vf[:, None], dist, None, sink)
    return o.reshape(B, T, SWA_HEADS * SWA_HD), kf[:, -L:], vf[:, -L:]


def _mem_kv(mem, g, w_kv, kn_g):
    B, M = mem.shape[0], mem.shape[1]
    mk, mv = jnp.split(_rms(mem, g) @ w_kv, 2, axis=-1)
    mk = _rms(mk.reshape(B, M, MEM_HEADS, MEM_HD), kn_g)
    return mk, mv.reshape(B, M, MEM_HEADS, MEM_HD)


def _mem_attend(q, mk, mv):
    s = jnp.einsum('bthd,bmhd->bhtm', q, mk.astype(q.dtype)).astype(jnp.float32) * (MEM_HD ** -0.5)
    pr = jax.nn.softmax(s, axis=-1)
    return jnp.einsum('bhtm,bmhd->bthd', pr.astype(q.dtype), mv.astype(q.dtype))


def _layer(x, lw, mem_k, mem_v, shift_in, s0, conv_in, swa_k_cache, swa_v_cache):
    B, T = x.shape[0], x.shape[1]
    h = _rms(x, lw['norm1_g'])
    proj = h @ lw['w_in']
    p_rwkv, q, k, v, qm, gates = jnp.split(proj, _split_points(IN_SIZES), axis=-1)
    o_a, s_new, shift_new = _rwkv(p_rwkv, shift_in, s0, lw['rwkv_mu'], lw['rwkv_w0'], lw['rwkv_w2'], lw['rwkv_a0'],
                                  lw['rwkv_a2'], lw['rwkv_g2'], lw['rwkv_kk'], lw['rwkv_ka'], lw['rwkv_rk'],
                                  lw['rwkv_ln_g'], lw['rwkv_ln_b'])
    q = _rms(q.reshape(B, T, SWA_HEADS, SWA_HD), lw['swa_qn_g'])
    k = _rms(k.reshape(B, T, SWA_KV_HEADS, SWA_HD), lw['swa_kn_g'])
    v = v.reshape(B, T, SWA_KV_HEADS, SWA_HD)
    if swa_k_cache is None:
        o_b = _swa_prompt(q, k, v, lw['swa_sink'])
        kw, vw = k[:, -WINDOW:], v[:, -WINDOW:]
    else:
        o_b, kw, vw = _swa_sample(q, k, v, swa_k_cache, swa_v_cache, lw['swa_sink'])
    qm = _rms(qm.reshape(B, T, MEM_HEADS, MEM_HD), lw['mem_qn_g'])
    o_m = _mem_attend(qm, mem_k, mem_v).reshape(B, T, MEM_W)
    br = jnp.einsum('btnc,ncd->btnd', jnp.stack([o_a, o_b, o_m], axis=2), lw['w_branch'])
    gt = jax.nn.sigmoid(gates.reshape(B, T, N_BRANCH, D_MODEL))
    x = x + jnp.sum(gt * br, axis=2) @ lw['w_out']
    h = _rms(x, lw['norm2_g'])
    a_in, u = jnp.split(h @ lw['w_up'], 2, axis=-1)
    a_pad = jnp.concatenate([conv_in.astype(a_in.dtype), a_in], axis=1)
    c = lw['conv_b'] + sum([a_pad[:, j:j + T] * lw['conv_w'][j] for j in range(CONV_W)])
    x = x + (jax.nn.gelu(c) * u) @ lw['w_down']
    return x, (kw, vw, s_new, shift_new, a_pad[:, -(CONV_W - 1):])


def setup_inputs(seed: int = 0) -> dict:
    key = jax.random.key(seed)
    ks = iter(jax.random.split(key, 48))
    nrm = lambda shape, scale: jax.random.normal(next(ks), shape, jnp.float32) * scale
    L = DEPTH
    swa_len = min(WINDOW, PAST_LEN)
    return {
        'x_prompt': nrm((BATCH, SEQ, D_MODEL), 1.0),
        'x_sample': nrm((DEC_BATCH, DEC_SEQ, D_MODEL), 1.0),
        'cache_swa_k': nrm((L, DEC_BATCH, swa_len, SWA_KV_HEADS, SWA_HD), 1.0),
        'cache_swa_v': nrm((L, DEC_BATCH, swa_len, SWA_KV_HEADS, SWA_HD), 1.0),
        'cache_mem_k': nrm((L, DEC_BATCH, MEM_TOKENS, MEM_HEADS, MEM_HD), 1.0),
        'cache_mem_v': nrm((L, DEC_BATCH, MEM_TOKENS, MEM_HEADS, MEM_HD), 1.0),
        'state_rwkv': nrm((L, DEC_BATCH, RWKV_HEADS, RWKV_HD, RWKV_HD), 0.1),
        'state_shift': nrm((L, DEC_BATCH, 1, RWKV_COLS), 1.0),
        'state_conv': nrm((L, DEC_BATCH, CONV_W - 1, D_FF), 1.0),
        'mem_prompt': nrm((BATCH, MEM_TOKENS, D_MODEL), 1.0),
        'norm1_g': 1.0 + nrm((L, D_MODEL), 0.02),
        'w_in': nrm((L, D_MODEL, IN_COLS), D_MODEL ** -0.5),
        'rwkv_mu': jax.random.uniform(next(ks), (L, RWKV_COLS), jnp.float32),
        'rwkv_w0': jax.random.uniform(next(ks), (L, RWKV_W), jnp.float32, -6.0, -1.0),
        'rwkv_w2': nrm((L, DECAY_LORA, RWKV_W), 0.1 * DECAY_LORA ** -0.5),
        'rwkv_a0': nrm((L, RWKV_W), 0.5),
        'rwkv_a2': nrm((L, AAA_LORA, RWKV_W), 0.5 * AAA_LORA ** -0.5),
        'rwkv_g2': nrm((L, GATE_LORA, RWKV_W), GATE_LORA ** -0.5),
        'rwkv_kk': 0.85 + nrm((L, RWKV_W), 0.02),
        'rwkv_ka': 1.0 + nrm((L, RWKV_W), 0.02),
        'rwkv_rk': nrm((L, RWKV_HEADS, RWKV_HD), 0.1),
        'rwkv_ln_g': 1.0 + nrm((L, RWKV_W), 0.02),
        'rwkv_ln_b': nrm((L, RWKV_W), 0.02),
        'swa_qn_g': 1.0 + nrm((L, SWA_HD), 0.02),
        'swa_kn_g': 1.0 + nrm((L, SWA_HD), 0.02),
        'swa_sink': nrm((L, SWA_HEADS), 0.5),
        'mem_norm_g': 1.0 + nrm((L, D_MODEL), 0.02),
        'w_mem_kv': nrm((L, D_MODEL, 2 * MEM_W), D_MODEL ** -0.5),
        'mem_qn_g': 1.0 + nrm((L, MEM_HD), 0.02),
        'mem_kn_g': 1.0 + nrm((L, MEM_HD), 0.02),
        'w_branch': nrm((L, N_BRANCH, BR_W, D_MODEL), BR_W ** -0.5),
        'w_out': nrm((L, D_MODEL, D_MODEL), D_MODEL ** -0.5),
        'norm2_g': 1.0 + nrm((L, D_MODEL), 0.02),
        'w_up': nrm((L, D_MODEL, 2 * D_FF), D_MODEL ** -0.5),
        'conv_w': nrm((L, CONV_W, D_FF), CONV_W ** -0.5),
        'conv_b': nrm((L, D_FF), 0.02),
        'w_down': nrm((L, D_FF, D_MODEL), D_FF ** -0.5),
    }


def reference(x_prompt, x_sample, cache_swa_k, cache_swa_v, cache_mem_k, cache_mem_v, state_rwkv, state_shift,
              state_conv, mem_prompt, norm1_g, w_in, rwkv_mu, rwkv_w0, rwkv_w2, rwkv_a0, rwkv_a2, rwkv_g2, rwkv_kk,
              rwkv_ka, rwkv_rk, rwkv_ln_g, rwkv_ln_b, swa_qn_g, swa_kn_g, swa_sink, mem_norm_g, w_mem_kv, mem_qn_g,
              mem_kn_g, w_branch, w_out, norm2_g, w_up, conv_w, conv_b, w_down):
    Bp = x_prompt.shape[0]
    dt = x_prompt.dtype
    yp, ys = x_prompt, x_sample
    swk_p, swv_p, mk_p, mv_p, rw_p, sh_p, cv_p = [], [], [], [], [], [], []
    swk_s, swv_s, rw_s, sh_s, cv_s = [], [], [], [], []
    for l in range(DEPTH):
        lw = {'norm1_g': norm1_g[l], 'w_in': w_in[l], 'rwkv_mu': rwkv_mu[l], 'rwkv_w0': rwkv_w0[l],
              'rwkv_w2': rwkv_w2[l], 'rwkv_a0': rwkv_a0[l], 'rwkv_a2': rwkv_a2[l], 'rwkv_g2': rwkv_g2[l],
              'rwkv_kk': rwkv_kk[l], 'rwkv_ka': rwkv_ka[l], 'rwkv_rk': rwkv_rk[l], 'rwkv_ln_g': rwkv_ln_g[l],
              'rwkv_ln_b': rwkv_ln_b[l], 'swa_qn_g': swa_qn_g[l], 'swa_kn_g': swa_kn_g[l], 'swa_sink': swa_sink[l],
              'mem_qn_g': mem_qn_g[l], 'w_branch': w_branch[l], 'w_out': w_out[l], 'norm2_g': norm2_g[l],
              'w_up': w_up[l], 'conv_w': conv_w[l], 'conv_b': conv_b[l], 'w_down': w_down[l]}
        mk, mv = _mem_kv(mem_prompt, mem_norm_g[l], w_mem_kv[l], mem_kn_g[l])
        yp, (kw, vw, s_new, sh_new, cv_new) = _layer(
            yp, lw, mk, mv,
            jnp.zeros((Bp, 1, RWKV_COLS), dt),
            jnp.zeros((Bp, RWKV_HEADS, RWKV_HD, RWKV_HD), dt),
            jnp.zeros((Bp, CONV_W - 1, D_FF), dt), None, None)
        swk_p.append(kw); swv_p.append(vw); mk_p.append(mk); mv_p.append(mv)
        rw_p.append(s_new); sh_p.append(sh_new); cv_p.append(cv_new)
        ys, (kw, vw, s_new, sh_new, cv_new) = _layer(
            ys, lw, cache_mem_k[l], cache_mem_v[l], state_shift[l], state_rwkv[l], state_conv[l],
            cache_swa_k[l], cache_swa_v[l])
        swk_s.append(kw); swv_s.append(vw); rw_s.append(s_new); sh_s.append(sh_new); cv_s.append(cv_new)
    return (yp, ys,
            jnp.stack(swk_p), jnp.stack(swv_p), jnp.stack(mk_p), jnp.stack(mv_p),
            jnp.stack(rw_p), jnp.stack(sh_p), jnp.stack(cv_p),
            jnp.stack(swk_s), jnp.stack(swv_s), jnp.stack(rw_s), jnp.stack(sh_s), jnp.stack(cv_s))
```

```cpp
#include <hip/hip_runtime.h>
#include <hip/hip_cooperative_groups.h>
#include <cstdio>
namespace cg = cooperative_groups;

typedef unsigned short bf16_t;
typedef short bf16x8 __attribute__((ext_vector_type(8)));
typedef float f32x4 __attribute__((ext_vector_type(4)));
typedef unsigned u32x4 __attribute__((ext_vector_type(4)));
typedef unsigned u32x2 __attribute__((ext_vector_type(2)));
#define DI __device__ __forceinline__

constexpr int DM = 1024, TP = 16384, TS = 2048, MT = 18432;
constexpr int RC = 1792, MIXC = 3072, DFF = 2816;
constexpr int C_R = 0, C_K = 512, C_V = 1024, C_X = 1536, C_Q = 1792, C_SK = 2304, C_SV = 2432, C_QM = 2560;
constexpr float RMS_EPS = 1e-6f, GN_EPS = 64e-5f;

constexpr size_t O_Y = 0;
constexpr size_t O_SWK_P = (size_t)MT * DM;
constexpr size_t O_SWV_P = O_SWK_P + 131072;
constexpr size_t O_MK_P = O_SWV_P + 131072;
constexpr size_t O_MV_P = O_MK_P + 1048576;
constexpr size_t O_RW_P = O_MV_P + 1048576;
constexpr size_t O_SH_P = O_RW_P + 262144;
constexpr size_t O_CV_P = O_SH_P + 14336;
constexpr size_t O_SWK_S = O_CV_P + 45056;
constexpr size_t O_SWV_S = O_SWK_S + 1048576;
constexpr size_t O_RW_S = O_SWV_S + 1048576;
constexpr size_t O_SH_S = O_RW_S + 2097152;
constexpr size_t O_CV_S = O_SH_S + 114688;

constexpr size_t WS_CTR = 0;
constexpr size_t WS_BAR = 4096;
constexpr size_t WS_RS1 = 4096 + 16384;
constexpr size_t WS_RS2 = WS_RS1 + 73728;
constexpr size_t WS_RSM = WS_RS2 + 73728;
constexpr size_t WS_BON = WS_RSM + 4096;
constexpr size_t WS_WIN = WS_BON + 589824;
constexpr size_t WS_WUP = WS_WIN + 12582912;
constexpr size_t WS_WDN = WS_WUP + 11534336;
constexpr size_t WS_WBR = WS_WDN + 5767168;
constexpr size_t WS_WOUT = WS_WBR + 3145728;
constexpr size_t WS_WMKV = WS_WOUT + 2097152;
constexpr size_t WS_WW2 = WS_WMKV + 2097152;
constexpr size_t WS_WA2 = WS_WW2 + 65536;
constexpr size_t WS_WG2 = WS_WA2 + 65536;
constexpr size_t WS_P = WS_WG2 + 131072;
constexpr size_t WS_R = WS_P + 113246208;
constexpr size_t WS_LD = WS_R;
constexpr size_t WS_AA = WS_LD + 18874368;
constexpr size_t WS_LIN = WS_AA + 18874368;
constexpr size_t WS_OA = WS_LIN + 9437184;
constexpr size_t WS_OB = WS_OA + 18874368;
constexpr size_t WS_OM = WS_OB + 18874368;
constexpr size_t WS_VSP = WS_R + 103809024;
constexpr int VSP_LD = 4224;
constexpr size_t WS_VSS = WS_VSP + (size_t)4 * 2 * 64 * VSP_LD * 2;
constexpr size_t WS_VM = WS_VSS + (size_t)32 * 2 * 64 * 192 * 2;
constexpr size_t WS_XB = WS_VM + (size_t)36 * 4 * 128 * 256 * 2;
constexpr size_t WS_END = WS_XB + (size_t)(MT + 1024) * 1024 * 2;

struct Params {
  const float* in[37];
  float* out;
  unsigned char* ws;
};
typedef const __attribute__((address_space(4))) Params* PP;

DI int tidx() { int t = __builtin_amdgcn_workitem_id_x(); asm volatile("" : "+v"(t)); return t; }
DI float bf2f(bf16_t h) { return __uint_as_float(((unsigned)h) << 16); }
typedef float f32x2 __attribute__((ext_vector_type(2)));
typedef __bf16 bf16v2 __attribute__((ext_vector_type(2)));
DI unsigned pack2(float lo, float hi) { f32x2 v = {lo, hi}; bf16v2 b = __builtin_convertvector(v, bf16v2); return __builtin_bit_cast(unsigned, b); }
DI bf16_t f2bf(float x) { return (bf16_t)(pack2(x, 0.f) & 0xffffu); }
DI float lo16(unsigned u) { return __uint_as_float(u << 16); }
DI float hi16(unsigned u) { return __uint_as_float(u & 0xffff0000u); }
DI float sigmoidf_(float x) { return __builtin_amdgcn_rcpf(1.f + __expf(-x)); }
DI int tok_t(int m) { return m < TP ? (m & 4095) : (m & 63); }
DI int tok_b(int m) { return m < TP ? (m >> 12) : ((m - TP) >> 6); }
DI const float* xrow(const PP p, int l, int m) {
  return l == 0 ? (m < TP ? p->in[0] + (size_t)m * DM : p->in[1] + (size_t)(m - TP) * DM) : p->out + (size_t)m * DM;
}
DI float shift_in(const PP p, int l, int m, int c) {
  return m < TP ? 0.f : p->in[7][((size_t)l * 32 + ((m - TP) >> 6)) * RC + c];
}
DI float wave_sum(float v) {
#pragma unroll
  for (int o = 32; o > 0; o >>= 1) v += __shfl_xor(v, o);
  return v;
}
template <int CTRL> DI float dpp_add(float x) {
  return x + __int_as_float(__builtin_amdgcn_update_dpp(0, __float_as_int(x), CTRL, 0xf, 0xf, true));
}
DI float allreduce16(float x) {
  x = dpp_add<0xB1>(x);
  x = dpp_add<0x4E>(x);
  x = dpp_add<0x141>(x);
  x = dpp_add<0x140>(x);
  return x;
}
DI bf16x8 cvt8(f32x4 a, f32x4 b) {
  u32x4 r; r[0] = pack2(a[0], a[1]); r[1] = pack2(a[2], a[3]); r[2] = pack2(b[0], b[1]); r[3] = pack2(b[2], b[3]);
  return __builtin_bit_cast(bf16x8, r);
}
#define MFMA16(a, b, c) __builtin_amdgcn_mfma_f32_16x16x32_bf16((a), (b), (c), 0, 0, 0)

constexpr int LSTR = 144;
typedef const void __attribute__((address_space(1)))* gptr_t;
typedef void __attribute__((address_space(3)))* lptr_t;
template <int MI, int NJ>
DI void gemm_acc(f32x4 (&acc)[MI][NJ], const bf16_t* Ap, int lda, const bf16_t* Bt, int ldb, int K, unsigned char* smem) {
  const int tid = tidx(), lane = tid & 63, w = tid >> 6, wm = w >> 1, wn = w & 1, l15 = lane & 15, quad = lane >> 4;
  constexpr int AROWS = MI * 32, BROWS = NJ * 32, STAGE = (AROWS + BROWS) * 128;
  const int nk = K >> 6;
  const int r_in = lane >> 3, ch = (lane & 7) ^ r_in;
  const bf16_t* ag = Ap + (size_t)(w * 8 + r_in) * lda + ch * 8;
  const bf16_t* bg = Bt + (size_t)(w * 8 + r_in) * ldb + ch * 8;
  unsigned char* dma = smem + w * 1024;
  auto issue = [&](int kt, int st) {
    unsigned char* sa = dma + st * STAGE;
#pragma unroll
    for (int i = 0; i < MI; ++i)
      __builtin_amdgcn_global_load_lds((gptr_t)(ag + (size_t)(i * 32) * lda + kt * 64), (lptr_t)(sa + i * 4096), 16, 0, 0);
#pragma unroll
    for (int i = 0; i < NJ; ++i)
      __builtin_amdgcn_global_load_lds((gptr_t)(bg + (size_t)(i * 32) * ldb + kt * 64), (lptr_t)(sa + AROWS * 128 + i * 4096), 16, 0, 0);
  };
  const int ro0 = (quad ^ (l15 & 7)) * 16, ro1 = ro0 ^ 64;
  const unsigned char* rA = smem + (wm * MI * 16 + l15) * 128;
  const unsigned char* rB = smem + AROWS * 128 + (wn * NJ * 16 + l15) * 128;
  __syncthreads();
  issue(0, 0);
  for (int kt = 0; kt < nk; ++kt) {
    asm volatile("s_waitcnt vmcnt(0)" ::: "memory");
    __syncthreads();
    const int so = (kt & 1) * STAGE;
    bf16x8 fb0[NJ], fa0[MI], fb1[NJ], fa1[MI];
#pragma unroll
    for (int j = 0; j < NJ; ++j) fb0[j] = *(const bf16x8*)(rB + so + j * 2048 + ro0);
#pragma unroll
    for (int i = 0; i < MI; ++i) fa0[i] = *(const bf16x8*)(rA + so + i * 2048 + ro0);
#pragma unroll
    for (int j = 0; j < NJ; ++j) fb1[j] = *(const bf16x8*)(rB + so + j * 2048 + ro1);
#pragma unroll
    for (int i = 0; i < MI; ++i) fa1[i] = *(const bf16x8*)(rA + so + i * 2048 + ro1);
    __builtin_amdgcn_sched_barrier(0);
    if (kt + 1 < nk) issue(kt + 1, (kt + 1) & 1);
    __builtin_amdgcn_sched_barrier(0);
#pragma unroll
    for (int i = 0; i < MI; ++i)
#pragma unroll
      for (int j = 0; j < NJ; ++j) acc[i][j] = MFMA16(fb0[j], fa0[i], acc[i][j]);
#pragma unroll
    for (int i = 0; i < MI; ++i)
#pragma unroll
      for (int j = 0; j < NJ; ++j) acc[i][j] = MFMA16(fb1[j], fa1[i], acc[i][j]);
  }
}
template <int MI, int NJ> DI void zero_acc(f32x4 (&acc)[MI][NJ]) {
#pragma unroll
  for (int i = 0; i < MI; ++i)
#pragma unroll
    for (int j = 0; j < NJ; ++j) acc[i][j] = (f32x4){0.f, 0.f, 0.f, 0.f};
}
#define EPI_IDX(MI_, NJ_)                                                                         \
  const int tid_ = tidx(), lane_ = tid_ & 63, w_ = tid_ >> 6, wm_ = w_ >> 1, wn_ = w_ & 1;         \
  const int l15_ = lane_ & 15, quad_ = lane_ >> 4;                                                 \
  const int mb_ = m0 + wm_ * (MI_) * 16 + l15_, nb_ = n0 + wn_ * (NJ_) * 16 + quad_ * 4;

template <int NJ>
DI void store_tile(const u32x2 (&ov)[4][NJ], bf16_t* dst, size_t ld, int m0, int n0, unsigned char* smem) {
  const int tid = tidx(), lane = tid & 63, w = tid >> 6, wm = w >> 1, wn = w & 1, l15 = lane & 15, quad = lane >> 4;
  constexpr int RS = NJ * 64 + 16;
  __syncthreads();
#pragma unroll
  for (int i = 0; i < 4; ++i)
#pragma unroll
    for (int j = 0; j < NJ; ++j)
      *(u32x2*)(smem + (wm * 64 + i * 16 + l15) * RS + (wn * NJ * 16 + j * 16 + quad * 4) * 2) = ov[i][j];
  __syncthreads();
  constexpr int CPR = NJ * 4;
#pragma unroll
  for (int k = 0; k < (128 * CPR) / 256; ++k) {
    const int c = tid + k * 256, row = c / CPR, ch = c % CPR;
    const u32x4 v = *(const u32x4*)(smem + row * RS + ch * 16);
    *(u32x4*)(dst + (size_t)(m0 + row) * ld + n0 + ch * 8) = v;
  }
}

template <int NJ>
DI void tile_flush(bf16_t* dst, size_t ld, int m0, int n0, unsigned char* smem) {
  const int tid = tidx();
  constexpr int RS = NJ * 64 + 16, CPR = NJ * 4;
  __syncthreads();
#pragma unroll
  for (int k = 0; k < (128 * CPR) / 256; ++k) {
    const int c = tid + k * 256, row = c / CPR, ch = c % CPR;
    const u32x4 v = *(const u32x4*)(smem + row * RS + ch * 16);
    *(u32x4*)(dst + (size_t)(m0 + row) * ld + n0 + ch * 8) = v;
  }
}

DI bool conv_desc(const PP p, int l, int t, const float*& src, bf16_t*& dst, int& K, int& N, const float*& sc, int& lt) {
  int base = 0;
#define MAT(SRC, DST, KK, NN, SC)                                                               \
  {                                                                                             \
    const int nt = ((KK) / 64) * ((NN) / 64);                                                   \
    if (t < base + nt) { src = (SRC); dst = (bf16_t*)(p->ws + (DST)); K = (KK); N = (NN); sc = (SC); lt = t - base; return true; } \
    base += nt;                                                                                 \
  }
  MAT(p->in[11] + (size_t)l * 1024 * 6144, WS_WIN, 1024, 6144, p->in[10] + l * 1024)
  MAT(p->in[33] + (size_t)l * 1024 * 5632, WS_WUP, 1024, 5632, p->in[32] + l * 1024)
  MAT(p->in[36] + (size_t)l * 2816 * 1024, WS_WDN, 2816, 1024, nullptr)
  MAT(p->in[30] + (size_t)(l * 3 + 0) * 512 * 1024, WS_WBR, 512, 1024, nullptr)
  MAT(p->in[30] + (size_t)(l * 3 + 1) * 512 * 1024, WS_WBR + 1048576, 512, 1024, nullptr)
  MAT(p->in[30] + (size_t)(l * 3 + 2) * 512 * 1024, WS_WBR + 2097152, 512, 1024, nullptr)
  MAT(p->in[31] + (size_t)l * 1024 * 1024, WS_WOUT, 1024, 1024, nullptr)
  MAT(p->in[27] + (size_t)l * 1024 * 1024, WS_WMKV, 1024, 1024, p->in[26] + l * 1024)
  MAT(p->in[14] + (size_t)l * 64 * 512, WS_WW2, 64, 512, nullptr)
  MAT(p->in[16] + (size_t)l * 64 * 512, WS_WA2, 64, 512, nullptr)
  MAT(p->in[17] + (size_t)l * 128 * 512, WS_WG2, 128, 512, nullptr)
#undef MAT
  return false;
}
constexpr int CONV_TILES = 16 * 96 + 16 * 88 + 44 * 16 + 3 * 8 * 16 + 256 + 256 + 8 + 8 + 16;

DI void row_stats3(const float* s0, const float* s1, const float* s2, float* d0, float* d1, float* d2, bf16_t* x0, bf16_t* x1, bf16_t* x2, int lane) {
  f32x4 v[3][4];
#pragma unroll
  for (int i = 0; i < 4; ++i) {
    v[0][i] = *(const f32x4*)(s0 + (i * 64 + lane) * 4);
    if (s1) v[1][i] = *(const f32x4*)(s1 + (i * 64 + lane) * 4);
    if (s2) v[2][i] = *(const f32x4*)(s2 + (i * 64 + lane) * 4);
  }
  const float* sp[3] = {s0, s1, s2};
  float* dp[3] = {d0, d1, d2};
  bf16_t* xp[3] = {x0, x1, x2};
#pragma unroll
  for (int r = 0; r < 3; ++r) {
    if (!sp[r]) continue;
    float ss = 0.f;
#pragma unroll
    for (int i = 0; i < 4; ++i) {
      const f32x4 a = v[r][i];
      ss += a[0] * a[0] + a[1] * a[1] + a[2] * a[2] + a[3] * a[3];
      u32x2 o; o[0] = pack2(a[0], a[1]); o[1] = pack2(a[2], a[3]);
      *(u32x2*)(xp[r] + (i * 64 + lane) * 4) = o;
    }
    ss = wave_sum(ss);
    if (lane == 0) *dp[r] = rsqrtf(ss * (1.f / 1024.f) + RMS_EPS);
  }
}

DI void phase_convert(const PP p, int l, unsigned char* smem) {
  float* lds = (float*)smem;
  const int tid = tidx();
  {
    const float* src; bf16_t* dst; int K, N, lt; const float* sc;
    f32x4 v[4];
    float sv[4];
    int t = blockIdx.x, k0 = 0, n0 = 0;
    auto fetch = [&](int tt) {
      conv_desc(p, l, tt, src, dst, K, N, sc, lt);
      const int ntn = N >> 6;
      k0 = (lt / ntn) * 64; n0 = (lt % ntn) * 64;
#pragma unroll
      for (int ps = 0; ps < 4; ++ps) {
        const int r = ps * 16 + (tid >> 4), c = (tid & 15) * 4;
        v[ps] = *(const f32x4*)(src + (size_t)(k0 + r) * N + n0 + c);
        sv[ps] = sc ? sc[k0 + r] : 1.f;
      }
    };
    if (t < CONV_TILES) fetch(t);
    while (t < CONV_TILES) {
      __syncthreads();
#pragma unroll
      for (int ps = 0; ps < 4; ++ps) {
        const int r = ps * 16 + (tid >> 4), c = (tid & 15) * 4;
        const float s = sv[ps];
        lds[r * 65 + c] = v[ps][0] * s; lds[r * 65 + c + 1] = v[ps][1] * s; lds[r * 65 + c + 2] = v[ps][2] * s; lds[r * 65 + c + 3] = v[ps][3] * s;
      }
      __syncthreads();
      bf16_t* dcur = dst; const int Kc = K, k0c = k0, n0c = n0;
      const int tn = t + gridDim.x;
      if (tn < CONV_TILES) fetch(tn);
#pragma unroll
      for (int e = 0; e < 2; ++e) {
        const int idx = tid + e * 256, n = idx >> 3, kg = idx & 7;
        u32x4 o;
#pragma unroll
        for (int i = 0; i < 4; ++i) o[i] = pack2(lds[(kg * 8 + 2 * i) * 65 + n], lds[(kg * 8 + 2 * i + 1) * 65 + n]);
        *(u32x4*)(dcur + (size_t)(n0c + n) * Kc + k0c + kg * 8) = o;
      }
      t = tn;
    }
  }
  const int lane = tid & 63, gw = blockIdx.x * 4 + (tid >> 6), nw = gridDim.x * 4;
  float* rs1 = (float*)(p->ws + WS_RS1);
  float* rsm = (float*)(p->ws + WS_RSM);
  bf16_t* XB = (bf16_t*)(p->ws + WS_XB);
  auto srcrow = [&](int row) -> const float* { return row >= MT + 1024 ? nullptr : (row < MT ? xrow(p, l, row) : p->in[9] + (size_t)(row - MT) * 1024); };
  auto dstrow = [&](int row) -> float* { return row < MT ? rs1 + row : rsm + (row - MT); };
  for (int row = gw; row < MT + 1024; row += 3 * nw)
    row_stats3(srcrow(row), srcrow(row + nw), srcrow(row + 2 * nw), dstrow(row), dstrow(row + nw), dstrow(row + 2 * nw),
               XB + (size_t)row * 1024, XB + (size_t)(row + nw) * 1024, XB + (size_t)(row + 2 * nw) * 1024, lane);
}

DI void phase_stats2(const PP p) {
  const int tid = tidx(), lane = tid & 63, gw = blockIdx.x * 4 + (tid >> 6), nw = gridDim.x * 4;
  float* rs2 = (float*)(p->ws + WS_RS2);
  bf16_t* XB = (bf16_t*)(p->ws + WS_XB);
  auto srcrow = [&](int row) -> const float* { return row >= MT ? nullptr : p->out + (size_t)row * DM; };
  for (int row = gw; row < MT; row += 3 * nw)
    row_stats3(srcrow(row), srcrow(row + nw), srcrow(row + 2 * nw), rs2 + row, rs2 + row + nw, rs2 + row + 2 * nw,
               XB + (size_t)row * 1024, XB + (size_t)(row + nw) * 1024, XB + (size_t)(row + 2 * nw) * 1024, lane);
}

DI void phase_gemm_in(const PP p, int l, unsigned char* smem) {
  bf16_t* P = (bf16_t*)(p->ws + WS_P);
  const float* rs1 = (const float*)(p->ws + WS_RS1);
  const float* rsm = (const float*)(p->ws + WS_RSM);
  const int NT1 = 144 * 24;
  for (int t = blockIdx.x; t < NT1 + 64; t += gridDim.x) {
    f32x4 acc[4][4];
    zero_acc<4, 4>(acc);
    if (t < NT1) {
      const int m0 = (t / 24) * 128, n0 = (t % 24) * 128;
      gemm_acc<4, 4>(acc, (const bf16_t*)(p->ws + WS_XB) + (size_t)m0 * 1024, 1024, (const bf16_t*)(p->ws + WS_WIN) + (size_t)n0 * 1024, 1024, 1024, smem);
      EPI_IDX(4, 4)
      u32x2 ov[4][4];
#pragma unroll
      for (int i = 0; i < 4; ++i) {
        const int m = mb_ + i * 16;
        const float rs = rs1[m];
        const int t_ = tok_t(m);
        const bool last = m < TP ? (t_ == 4095) : (t_ == 63);
#pragma unroll
        for (int j = 0; j < 4; ++j) {
          const int n = nb_ + j * 16;
          f32x4 v = acc[i][j] * rs;
          u32x2 o; o[0] = pack2(v[0], v[1]); o[1] = pack2(v[2], v[3]);
          ov[i][j] = o;
          if (last && n < RC) {
            float* so = m < TP ? p->out + O_SH_P + ((size_t)l * 4 + (m >> 12)) * RC + n : p->out + O_SH_S + ((size_t)l * 32 + ((m - TP) >> 6)) * RC + n;
            *(f32x4*)so = v;
          }
        }
      }
      store_tile<4>(ov, P, MIXC, m0, n0, smem);
    } else {
      const int tt = t - NT1, m0 = (tt >> 3) * 128, n0 = (tt & 7) * 128;
      gemm_acc<4, 4>(acc, (const bf16_t*)(p->ws + WS_XB) + (size_t)(MT + m0) * 1024, 1024, (const bf16_t*)(p->ws + WS_WMKV) + (size_t)n0 * 1024, 1024, 1024, smem);
      EPI_IDX(4, 4)
#pragma unroll
      for (int i = 0; i < 4; ++i) {
        const int m = mb_ + i * 16;
        const float rs = rsm[m];
#pragma unroll
        for (int j = 0; j < 4; ++j) {
          const int n = nb_ + j * 16;
          f32x4 v = acc[i][j] * rs;
          float* dst = n < 512 ? p->out + O_MK_P + ((size_t)l * 1024 + m) * 512 + n : p->out + O_MV_P + ((size_t)l * 1024 + m) * 512 + (n - 512);
          *(f32x4*)dst = v;
        }
      }
    }
  }
}

DI void phase_prep(const PP p, int l) {
  bf16_t* P = (bf16_t*)(p->ws + WS_P);
  const int g0 = blockIdx.x * 256 + tidx(), G = gridDim.x * 256;
  {
    bf16_t* LIN = (bf16_t*)(p->ws + WS_LIN);
    const float* mu = p->in[12] + l * RC;
    for (int idx = g0; idx < MT * 32; idx += G) {
      const int m = idx >> 5, c8 = (idx & 31) * 8, t = tok_t(m);
      u32x4 cur = *(const u32x4*)(P + (size_t)m * MIXC + C_X + c8);
      u32x4 prv = (u32x4){0u, 0u, 0u, 0u};
      if (t > 0) prv = *(const u32x4*)(P + (size_t)(m - 1) * MIXC + C_X + c8);
      u32x4 o;
#pragma unroll
      for (int i = 0; i < 4; ++i) {
        float c0 = lo16(cur[i]), c1 = hi16(cur[i]);
        float p0, p1;
        if (t > 0) { p0 = lo16(prv[i]); p1 = hi16(prv[i]); }
        else { p0 = shift_in(p, l, m, C_X + c8 + 2 * i); p1 = shift_in(p, l, m, C_X + c8 + 2 * i + 1); }
        float v0 = c0 + (p0 - c0) * mu[C_X + c8 + 2 * i], v1 = c1 + (p1 - c1) * mu[C_X + c8 + 2 * i + 1];
        if (c8 < 64) { v0 = 2.f * sigmoidf_(2.f * v0) - 1.f; v1 = 2.f * sigmoidf_(2.f * v1) - 1.f; }
        else if (c8 >= 128) { v0 = sigmoidf_(v0); v1 = sigmoidf_(v1); }
        o[i] = pack2(v0, v1);
      }
      *(u32x4*)(LIN + (size_t)m * 256 + c8) = o;
    }
  }
  {
    const float* kg = p->in[24] + l * 64;
    for (int idx = g0; idx < MT * 2; idx += G) {
      const int m = idx >> 1, kvh = idx & 1, t = tok_t(m), b = tok_b(m);
      bf16_t* kp = P + (size_t)m * MIXC + C_SK + kvh * 64;
      float ss = 0.f;
#pragma unroll
      for (int i = 0; i < 8; ++i) {
        u32x4 v = *(const u32x4*)(kp + i * 8);
#pragma unroll
        for (int e = 0; e < 4; ++e) { float a = lo16(v[e]), c = hi16(v[e]); ss += a * a + c * c; }
      }
      const float rs = rsqrtf(ss * (1.f / 64.f) + RMS_EPS);
      float* ko = nullptr;
      if (m < TP) { if (t >= 3968) ko = p->out + O_SWK_P + (((size_t)l * 4 + b) * 128 + (t - 3968)) * 128 + kvh * 64; }
      else ko = p->out + O_SWK_S + (((size_t)l * 32 + b) * 128 + 64 + t) * 128 + kvh * 64;
#pragma unroll
      for (int i = 0; i < 8; ++i) {
        u32x4 v = *(const u32x4*)(kp + i * 8);
        u32x4 o;
#pragma unroll
        for (int e = 0; e < 4; ++e) {
          float a = lo16(v[e]) * rs * kg[i * 8 + 2 * e], c = hi16(v[e]) * rs * kg[i * 8 + 2 * e + 1];
          o[e] = pack2(a, c);
          if (ko) { ko[i * 8 + 2 * e] = a; ko[i * 8 + 2 * e + 1] = c; }
        }
        *(u32x4*)(kp + i * 8) = o;
      }
    }
  }
  {
    for (int idx = g0; idx < 4 * 128 * 128; idx += G) {
      const int c = idx & 127, j = (idx >> 7) & 127, b = idx >> 14;
      p->out[O_SWV_P + (((size_t)l * 4 + b) * 128 + j) * 128 + c] = bf2f(P[(size_t)(b * 4096 + 3968 + j) * MIXC + C_SV + c]);
    }
    for (int idx = g0; idx < 32 * 128 * 128; idx += G) {
      const int c = idx & 127, j = (idx >> 7) & 127, b = idx >> 14;
      const size_t o = (((size_t)l * 32 + b) * 128 + j) * 128 + c;
      if (j < 64) {
        const size_t s = (((size_t)l * 32 + b) * 128 + 64 + j) * 128 + c;
        p->out[O_SWK_S + o] = p->in[2][s];
        p->out[O_SWV_S + o] = p->in[3][s];
      } else {
        p->out[O_SWV_S + o] = bf2f(P[(size_t)(TP + b * 64 + (j - 64)) * MIXC + C_SV + c]);
      }
    }
  }
  {
    bf16_t* VSP = (bf16_t*)(p->ws + WS_VSP);
    for (int idx = g0; idx < 8 * 528 * 64; idx += G) {
      const int d = idx & 63, rest = idx >> 6, c8 = (rest % 528) * 8, bk = rest / 528, b = bk >> 1, kvh = bk & 1;
      u32x4 o = (u32x4){0u, 0u, 0u, 0u};
      if (c8 >= 128) {
        const bf16_t* s = P + (size_t)(b * 4096 + c8 - 128) * MIXC + C_SV + kvh * 64 + d;
#pragma unroll
        for (int i = 0; i < 4; ++i) o[i] = (unsigned)s[(size_t)(2 * i) * MIXC] | ((unsigned)s[(size_t)(2 * i + 1) * MIXC] << 16);
      }
      *(u32x4*)(VSP + ((size_t)bk * 64 + d) * VSP_LD + c8) = o;
    }
    bf16_t* VSS = (bf16_t*)(p->ws + WS_VSS);
    for (int idx = g0; idx < 64 * 24 * 64; idx += G) {
      const int d = idx & 63, rest = idx >> 6, c8 = (rest % 24) * 8, bk = rest / 24, b = bk >> 1, kvh = bk & 1;
      u32x4 o;
      if (c8 < 128) {
        const float* s = p->in[3] + (((size_t)l * 32 + b) * 128 + c8) * 128 + kvh * 64 + d;
#pragma unroll
        for (int i = 0; i < 4; ++i) o[i] = pack2(s[(2 * i) * 128], s[(2 * i + 1) * 128]);
      } else {
        const bf16_t* s = P + (size_t)(TP + b * 64 + c8 - 128) * MIXC + C_SV + kvh * 64 + d;
#pragma unroll
        for (int i = 0; i < 4; ++i) o[i] = (unsigned)s[(size_t)(2 * i) * MIXC] | ((unsigned)s[(size_t)(2 * i + 1) * MIXC] << 16);
      }
      *(u32x4*)(VSS + ((size_t)bk * 64 + d) * 192 + c8) = o;
    }
    bf16_t* VM = (bf16_t*)(p->ws + WS_VM);
    for (int idx = g0; idx < 144 * 32 * 128; idx += G) {
      const int d = idx & 127, rest = idx >> 7, m8 = (rest & 31) * 8, bh = rest >> 5, bb = bh >> 2, h = bh & 3;
      const float* s = bb < 4 ? p->out + O_MV_P + (((size_t)l * 4 + bb) * 256 + m8) * 512 + h * 128 + d
                              : p->in[5] + (((size_t)l * 32 + (bb - 4)) * 256 + m8) * 512 + h * 128 + d;
      u32x4 o;
#pragma unroll
      for (int i = 0; i < 4; ++i) o[i] = pack2(s[(2 * i) * 512], s[(2 * i + 1) * 512]);
      *(u32x4*)(VM + ((size_t)bh * 128 + d) * 256 + m8) = o;
    }
  }
  {
    const float* kg = p->in[29] + l * 128;
    for (int idx = g0; idx < 4096; idx += G) {
      float* kp = p->out + O_MK_P + (size_t)l * 1024 * 512 + (size_t)idx * 128;
      float ss = 0.f;
#pragma unroll 4
      for (int i = 0; i < 32; ++i) { f32x4 v = *(const f32x4*)(kp + i * 4); ss += v[0] * v[0] + v[1] * v[1] + v[2] * v[2] + v[3] * v[3]; }
      const float rs = rsqrtf(ss * (1.f / 128.f) + RMS_EPS);
#pragma unroll 4
      for (int i = 0; i < 32; ++i) {
        f32x4 v = *(const f32x4*)(kp + i * 4);
        f32x4 g = *(const f32x4*)(kg + i * 4);
        *(f32x4*)(kp + i * 4) = v * rs * g;
      }
    }
  }
}

DI void phase_lora(const PP p, int l, unsigned char* smem) {
  const bf16_t* LIN = (const bf16_t*)(p->ws + WS_LIN);
  for (int t = blockIdx.x; t < 144 * 4 * 2; t += gridDim.x) {
    const int which = t / 576, tt = t % 576, m0 = (tt >> 2) * 128, n0 = (tt & 3) * 128;
    f32x4 acc[4][4];
    zero_acc<4, 4>(acc);
    gemm_acc<4, 4>(acc, LIN + (size_t)m0 * 256 + which * 64, 256, (const bf16_t*)(p->ws + (which ? WS_WA2 : WS_WW2)) + (size_t)n0 * 64, 64, 64, smem);
    bf16_t* dst = (bf16_t*)(p->ws + (which ? WS_AA : WS_LD));
    const float* bias = (which ? p->in[15] : p->in[13]) + l * 512;
    EPI_IDX(4, 4)
    u32x2 ov[4][4];
#pragma unroll
    for (int i = 0; i < 4; ++i) {
      const int m = mb_ + i * 16;
#pragma unroll
      for (int j = 0; j < 4; ++j) {
        const int n = nb_ + j * 16;
        f32x4 bv = *(const f32x4*)(bias + n);
        f32x4 v = acc[i][j] + bv;
#pragma unroll
        for (int r = 0; r < 4; ++r) {
          if (which) v[r] = sigmoidf_(v[r]);
          else v[r] = -0.6065306597126334f * sigmoidf_(v[r]);
        }
        ov[i][j][0] = pack2(v[0], v[1]); ov[i][j][1] = pack2(v[2], v[3]);
      }
    }
    store_tile<4>(ov, dst, 512, m0, n0, smem);
  }
}

DI void gates_tile(const PP p, int l, int m0, int n0, unsigned char* smem) {
  const float* rs1 = (const float*)(p->ws + WS_RS1);
  const bool early = n0 < 2048;
  bf16_t* G = early ? (bf16_t*)p->out : (bf16_t*)(p->ws + WS_P);
  const size_t ldg = early ? 2048 : MIXC;
  f32x4 acc[4][4];
  zero_acc<4, 4>(acc);
  gemm_acc<4, 4>(acc, (const bf16_t*)(p->ws + WS_XB) + (size_t)m0 * 1024, 1024, (const bf16_t*)(p->ws + WS_WIN) + (size_t)(MIXC + n0) * 1024, 1024, 1024, smem);
  EPI_IDX(4, 4)
  u32x2 ov[4][4];
#pragma unroll
  for (int i = 0; i < 4; ++i) {
    const float rs = rs1[mb_ + i * 16];
#pragma unroll
    for (int j = 0; j < 4; ++j) {
      f32x4 v = acc[i][j] * rs;
      ov[i][j][0] = pack2(sigmoidf_(v[0]), sigmoidf_(v[1])); ov[i][j][1] = pack2(sigmoidf_(v[2]), sigmoidf_(v[3]));
    }
  }
  store_tile<4>(ov, G, ldg, m0, n0, smem);
}

constexpr int TC = 32;
template <int CTRL> DI float dpp_mov(float x) {
  return __int_as_float(__builtin_amdgcn_update_dpp(0, __float_as_int(x), CTRL, 0xf, 0xf, true));
}
DI float allreduce8(float x) {
  x = dpp_add<0xB1>(x);
  x = dpp_add<0x4E>(x);
  x = dpp_add<0x141>(x);
  return x;
}
DI void unpack8(u32x4 v, float (&f)[8]) {
#pragma unroll
  for (int e = 0; e < 4; ++e) { f[2 * e] = lo16(v[e]); f[2 * e + 1] = hi16(v[e]); }
}
DI void rwkv_unit(const PP p, int l, int grp, int b, int h, int rg, unsigned char* smem) {
  const bf16_t* P = (const bf16_t*)(p->ws + WS_P);
  const bf16_t* LD = (const bf16_t*)(p->ws + WS_LD);
  const bf16_t* AA = (const bf16_t*)(p->ws + WS_AA);
  bf16_t* OA = (bf16_t*)(p->ws + WS_OA);
  float* BON = (float*)(p->ws + WS_BON);
  float* sr = (float*)smem;
  float* sw = sr + TC * 64;
  float* sk = sw + TC * 64;
  float* skk = sk + TC * 64;
  float* sb = skk + TC * 64;
  float* sv = sb + TC * 64;
  const int tid = tidx();
  const int row = tid >> 4, kq = tid & 15;
  const int stt = tid >> 3, kg = tid & 7;
  const int T = grp ? 64 : 4096;
  const int mbase = grp ? TP + b * 64 : b * 4096;
  const int vrow = rg * 16 + row;
  f32x4 S = (f32x4){0.f, 0.f, 0.f, 0.f};
  if (grp) S = *(const f32x4*)(p->in[6] + ((((size_t)l * 32 + b) * 8 + h) * 64 + vrow) * 64 + kq * 4);
  const int c0 = h * 64 + kg * 8;
  u32x4 cR, cK, cV, pR, pK, pV, aA, aL;
  auto issue = [&](int t0) {
    const int m = mbase + t0 + stt;
    const bf16_t* pr = P + (size_t)m * MIXC + c0;
    cR = *(const u32x4*)(pr + C_R); cK = *(const u32x4*)(pr + C_K); cV = *(const u32x4*)(pr + C_V);
    const bf16_t* pp = (t0 + stt > 0) ? pr - MIXC : pr;
    pR = *(const u32x4*)(pp + C_R); pK = *(const u32x4*)(pp + C_K); pV = *(const u32x4*)(pp + C_V);
    aA = *(const u32x4*)(AA + (size_t)m * 512 + c0);
    aL = *(const u32x4*)(LD + (size_t)m * 512 + c0);
  };
  issue(0);
  for (int t0 = 0; t0 < T; t0 += TC) {
    {
      const int t = t0 + stt, m = mbase + t;
      float fr[8], fk[8], fv[8], qr[8], qk[8], qv[8], fa[8], fl[8];
      unpack8(cR, fr); unpack8(cK, fk); unpack8(cV, fv);
      unpack8(pR, qr); unpack8(pK, qk); unpack8(pV, qv);
      unpack8(aA, fa); unpack8(aL, fl);
      if (t == 0) {
#pragma unroll
        for (int e = 0; e < 8; ++e) { qr[e] = shift_in(p, l, m, C_R + c0 + e); qk[e] = shift_in(p, l, m, C_K + c0 + e); qv[e] = shift_in(p, l, m, C_V + c0 + e); }
      }
      const float* mu = p->in[12] + l * RC;
      const float* kkw = p->in[18] + l * 512 + c0;
      const float* kaw = p->in[19] + l * 512 + c0;
      const float* rkw = p->in[20] + l * 512 + c0;
      float nn = 0.f, bn = 0.f;
      float kkv[8], km[8];
#pragma unroll
      for (int e = 0; e < 8; ++e) {
        fr[e] = fr[e] + (qr[e] - fr[e]) * mu[C_R + c0 + e];
        fk[e] = fk[e] + (qk[e] - fk[e]) * mu[C_K + c0 + e];
        fv[e] = fv[e] + (qv[e] - fv[e]) * mu[C_V + c0 + e];
        kkv[e] = fk[e] * kkw[e];
        nn += kkv[e] * kkv[e];
        km[e] = fk[e] * (1.f + (fa[e] - 1.f) * kaw[e]);
        bn += fr[e] * km[e] * rkw[e];
      }
      nn = allreduce8(nn);
      const float inv = __builtin_amdgcn_rsqf(fmaxf(nn, 1e-24f));
      float* d;
      d = sr + stt * 64 + kg * 8;
      *(f32x4*)d = (f32x4){fr[0], fr[1], fr[2], fr[3]}; *(f32x4*)(d + 4) = (f32x4){fr[4], fr[5], fr[6], fr[7]};
      d = sw + stt * 64 + kg * 8;
      *(f32x4*)d = (f32x4){__expf(fl[0]), __expf(fl[1]), __expf(fl[2]), __expf(fl[3])};
      *(f32x4*)(d + 4) = (f32x4){__expf(fl[4]), __expf(fl[5]), __expf(fl[6]), __expf(fl[7])};
      d = sk + stt * 64 + kg * 8;
      *(f32x4*)d = (f32x4){km[0], km[1], km[2], km[3]}; *(f32x4*)(d + 4) = (f32x4){km[4], km[5], km[6], km[7]};
      d = skk + stt * 64 + kg * 8;
      *(f32x4*)d = (f32x4){kkv[0] * inv, kkv[1] * inv, kkv[2] * inv, kkv[3] * inv};
      *(f32x4*)(d + 4) = (f32x4){kkv[4] * inv, kkv[5] * inv, kkv[6] * inv, kkv[7] * inv};
      d = sb + stt * 64 + kg * 8;
      *(f32x4*)d = (f32x4){kkv[0] * inv * fa[0], kkv[1] * inv * fa[1], kkv[2] * inv * fa[2], kkv[3] * inv * fa[3]};
      *(f32x4*)(d + 4) = (f32x4){kkv[4] * inv * fa[4], kkv[5] * inv * fa[5], kkv[6] * inv * fa[6], kkv[7] * inv * fa[7]};
      if ((kg >> 1) == rg) {
        d = sv + stt * 16 + (kg & 1) * 8;
        *(f32x4*)d = (f32x4){fv[0], fv[1], fv[2], fv[3]}; *(f32x4*)(d + 4) = (f32x4){fv[4], fv[5], fv[6], fv[7]};
      }
      if (rg == 0) {
        bn = allreduce8(bn);
        if (kg == 0) BON[(size_t)m * 8 + h] = bn;
      }
    }
    __syncthreads();
    if (t0 + TC < T) issue(t0 + TC);
    float ok0 = 0.f, ok1 = 0.f;
    const float* bs = (const float*)smem + kq * 4;
    f32x4 nkk = *(const f32x4*)(bs + 3 * TC * 64), nw = *(const f32x4*)(bs + TC * 64), nb = *(const f32x4*)(bs + 4 * TC * 64),
          nk = *(const f32x4*)(bs + 2 * TC * 64), nr = *(const f32x4*)bs;
    float nv = sv[row];
#pragma unroll
    for (int tt = 0; tt < TC; ++tt) {
      const f32x4 kk4 = nkk, w4 = nw, b4 = nb, k4 = nk, r4 = nr;
      const float v = nv;
      if (tt + 1 < TC) {
        const float* bn_ = bs + (tt + 1) * 64;
        nkk = *(const f32x4*)(bn_ + 3 * TC * 64); nw = *(const f32x4*)(bn_ + TC * 64); nb = *(const f32x4*)(bn_ + 4 * TC * 64);
        nk = *(const f32x4*)(bn_ + 2 * TC * 64); nr = *(const f32x4*)bn_;
        nv = sv[(tt + 1) * 16 + row];
      }
      float d = S[0] * kk4[0] + S[1] * kk4[1] + S[2] * kk4[2] + S[3] * kk4[3];
      d = allreduce16(d);
      const float sa = -d;
      S = S * w4 + sa * b4 + v * k4;
      float o = S[0] * r4[0] + S[1] * r4[1] + S[2] * r4[2] + S[3] * r4[3];
      o = allreduce16(o);
      if (tt < 16) ok0 = (kq == tt) ? o : ok0;
      else ok1 = (kq == tt - 16) ? o : ok1;
    }
    {
      bf16_t* so = (bf16_t*)(sv + TC * 16);
      so[kq * 16 + row] = f2bf(ok0);
      so[(16 + kq) * 16 + row] = f2bf(ok1);
      __syncthreads();
      if (tid < 64) {
        const int tk = tid >> 1, hf = tid & 1;
        *(u32x4*)(OA + (size_t)(mbase + t0 + tk) * 512 + h * 64 + rg * 16 + hf * 8) = *(const u32x4*)(so + tk * 16 + hf * 8);
      }
    }
  }
  float* sout = grp ? p->out + O_RW_S + ((((size_t)l * 32 + b) * 8 + h) * 64 + vrow) * 64 + kq * 4
                    : p->out + O_RW_P + ((((size_t)l * 4 + b) * 8 + h) * 64 + vrow) * 64 + kq * 4;
  *(f32x4*)sout = S;
}

template <int HD, int NKT, int MODE>
DI void attn16(const PP p, int l, const bf16_t* qrow, const float* qg, float qscale, const float* kf32, const bf16_t* kbf,
               const bf16_t* vt, int ldv, bf16_t* orow, int qi0, int chunk, float slope, float sink) {
  const int lane = tidx() & 63, l15 = lane & 15, quad = lane >> 4;
  constexpr int NKS = HD / 32;
  bf16x8 qf[NKS];
  {
    float qv[NKS][8];
    float ss = 0.f;
#pragma unroll
    for (int ks = 0; ks < NKS; ++ks) {
      u32x4 v = *(const u32x4*)(qrow + ks * 32 + quad * 8);
#pragma unroll
      for (int e = 0; e < 4; ++e) { qv[ks][2 * e] = lo16(v[e]); qv[ks][2 * e + 1] = hi16(v[e]); ss += qv[ks][2 * e] * qv[ks][2 * e] + qv[ks][2 * e + 1] * qv[ks][2 * e + 1]; }
    }
    ss += __shfl_xor(ss, 16);
    ss += __shfl_xor(ss, 32);
    const float rs = rsqrtf(ss * (1.f / HD) + RMS_EPS) * qscale;
#pragma unroll
    for (int ks = 0; ks < NKS; ++ks) {
      const float* g = qg + ks * 32 + quad * 8;
      u32x4 o;
#pragma unroll
      for (int e = 0; e < 4; ++e) o[e] = pack2(qv[ks][2 * e] * rs * g[2 * e], qv[ks][2 * e + 1] * rs * g[2 * e + 1]);
      qf[ks] = __builtin_bit_cast(bf16x8, o);
    }
  }
  f32x4 s[NKT];
  float mx = -INFINITY;
#pragma unroll
  for (int kt = 0; kt < NKT; ++kt) {
    f32x4 acc = (f32x4){0.f, 0.f, 0.f, 0.f};
    const int key = kt * 16 + l15;
#pragma unroll
    for (int ks = 0; ks < NKS; ++ks) {
      bf16x8 kfr;
      const int d0 = ks * 32 + quad * 8;
      if constexpr (MODE == 0 || MODE == 4) {
        const float* kp = kf32 + (size_t)key * 512 + d0;
        kfr = cvt8(*(const f32x4*)kp, *(const f32x4*)(kp + 4));
      } else if constexpr (MODE == 1) {
        int tokrel = (chunk - 2) * 64 + key;
        if (tokrel < 0) tokrel = 0;
        kfr = *(const bf16x8*)(kbf + (size_t)tokrel * MIXC + d0);
      } else if constexpr (MODE == 3) {
        kfr = *(const bf16x8*)((const unsigned char*)kbf + key * 128 + (((ks * 4 + quad) ^ (key & 7)) * 16));
      } else {
        if (kt < 8) {
          const float* kp = kf32 + (size_t)key * 128 + d0;
          kfr = cvt8(*(const f32x4*)kp, *(const f32x4*)(kp + 4));
        } else {
          kfr = *(const bf16x8*)(kbf + (size_t)(key - 128) * MIXC + d0);
        }
      }
      acc = MFMA16(kfr, qf[ks], acc);
    }
    if constexpr (MODE != 0 && MODE != 4) {
#pragma unroll
      for (int r = 0; r < 4; ++r) {
        const int kj = kt * 16 + quad * 4 + r;
        const float dist = fabsf((float)(128 + qi0 + l15 - kj));
        acc[r] = acc[r] - slope * dist;
        if ((MODE == 1 || MODE == 3) && (chunk - 2 + (kj >> 6)) < 0) acc[r] = -INFINITY;
      }
    }
    s[kt] = acc;
    mx = fmaxf(mx, fmaxf(fmaxf(acc[0], acc[1]), fmaxf(acc[2], acc[3])));
    __builtin_amdgcn_sched_barrier(0);
  }
  mx = fmaxf(mx, __shfl_xor(mx, 16));
  mx = fmaxf(mx, __shfl_xor(mx, 32));
  if constexpr (MODE != 0 && MODE != 4) mx = fmaxf(mx, sink);
  float sum = 0.f;
#pragma unroll
  for (int kt = 0; kt < NKT; ++kt)
#pragma unroll
    for (int r = 0; r < 4; ++r) { const float e = __expf(s[kt][r] - mx); s[kt][r] = e; sum += e; }
  sum += __shfl_xor(sum, 16);
  sum += __shfl_xor(sum, 32);
  if constexpr (MODE != 0 && MODE != 4) sum += __expf(sink - mx);
  const float inv = 1.f / sum;
  f32x4 o[HD / 16];
#pragma unroll
  for (int dt = 0; dt < HD / 16; ++dt) o[dt] = (f32x4){0.f, 0.f, 0.f, 0.f};
#pragma unroll
  for (int kb = 0; kb < NKT / 2; ++kb) {
    u32x4 pp;
    pp[0] = pack2(s[2 * kb][0], s[2 * kb][1]); pp[1] = pack2(s[2 * kb][2], s[2 * kb][3]);
    pp[2] = pack2(s[2 * kb + 1][0], s[2 * kb + 1][1]); pp[3] = pack2(s[2 * kb + 1][2], s[2 * kb + 1][3]);
    const bf16x8 pf = __builtin_bit_cast(bf16x8, pp);
#pragma unroll
    for (int dt = 0; dt < HD / 16; ++dt) {
      u32x2 v0, v1;
      if constexpr (MODE == 4) {
        const unsigned char* vr = (const unsigned char*)vt + (dt * 16 + l15) * 512 + (quad & 1) * 8;
        const int c0 = kb * 4 + (quad >> 1);
        v0 = *(const u32x2*)(vr + ((c0 ^ l15) * 16));
        v1 = *(const u32x2*)(vr + (((c0 + 2) ^ l15) * 16));
      } else {
        const bf16_t* vp = vt + (size_t)(dt * 16 + l15) * ldv + kb * 32 + quad * 4;
        v0 = *(const u32x2*)vp; v1 = *(const u32x2*)(vp + 16);
      }
      u32x4 vv; vv[0] = v0[0]; vv[1] = v0[1]; vv[2] = v1[0]; vv[3] = v1[1];
      o[dt] = MFMA16(__builtin_bit_cast(bf16x8, vv), pf, o[dt]);
    }
    __builtin_amdgcn_sched_barrier(0);
  }
#pragma unroll
  for (int dt = 0; dt < HD / 16; ++dt) {
    u32x2 ov; ov[0] = pack2(o[dt][0] * inv, o[dt][1] * inv); ov[1] = pack2(o[dt][2] * inv, o[dt][3] * inv);
    *(u32x2*)(orow + dt * 16 + quad * 4) = ov;
  }
}

constexpr int Q_REC_S = 1024, Q_SWA = 576, Q_MEM = 1152, Q_TOTAL = Q_REC_S + Q_SWA + Q_MEM;
DI void phase_mixers(const PP p, int l, unsigned char* smem, int slot) {
  const int tid = tidx(), w = tid >> 6, lane = tid & 63, l15 = lane & 15;
  const bf16_t* P = (const bf16_t*)(p->ws + WS_P);
  unsigned* ctr = (unsigned*)(p->ws + WS_CTR) + slot * 16;
  int* sitem = (int*)(smem + 65536 + 16);
  if (blockIdx.x < 128) rwkv_unit(p, l, 0, blockIdx.x >> 5, (blockIdx.x >> 2) & 7, blockIdx.x & 3, smem);
  const bool quiet_ = (gridDim.x == 512) && (blockIdx.x >= 256) && (blockIdx.x < 384);
  for (; !quiet_;) {
    __syncthreads();
    if (tid == 0) *sitem = (int)atomicAdd(ctr, 1u);
    __syncthreads();
    int item = *sitem;
    if (item >= Q_TOTAL) break;
    item = __builtin_amdgcn_readfirstlane(item);
    asm volatile("" : "+s"(item));
    if (item < Q_REC_S) {
      rwkv_unit(p, l, 1, item >> 5, (item >> 2) & 7, item & 3, smem);
    } else if (item < Q_REC_S + Q_SWA) {
      const int u = item - Q_REC_S;
      const float* qg = p->in[23] + l * 64;
      if (u < 512) {
        const int kvh = u & 1, chunk = (u >> 1) & 63, b = u >> 7, h = kvh * 4 + w;
        const float slope = exp2f(-(float)(h + 1)), sink = p->in[25][l * 8 + h];
        const bf16_t* kb = P + (size_t)(b * 4096) * MIXC + C_SK + kvh * 64;
        const bf16_t* vt = (const bf16_t*)(p->ws + WS_VSP) + (size_t)(b * 2 + kvh) * 64 * VSP_LD + chunk * 64;
        unsigned char* Kl = smem;
        bf16_t* Vl = (bf16_t*)(smem + 24576);
#pragma unroll 2
        for (int k = 0; k < 6; ++k) {
          const int idx = tid + k * 256, r = idx >> 3, c = idx & 7;
          int tokrel = (chunk - 2) * 64 + r;
          if (tokrel < 0) tokrel = 0;
          *(u32x4*)(Kl + r * 128 + ((c ^ (r & 7)) * 16)) = *(const u32x4*)(kb + (size_t)tokrel * MIXC + c * 8);
          const int d = idx / 24, ch = idx % 24;
          *(u32x4*)(Vl + d * 200 + ch * 8) = *(const u32x4*)(vt + (size_t)d * VSP_LD + ch * 8);
        }
        __syncthreads();
#pragma unroll 1
        for (int qs = 0; qs < 4; ++qs) {
          const int m = b * 4096 + chunk * 64 + qs * 16 + l15;
          attn16<64, 12, 3>(p, l, P + (size_t)m * MIXC + C_Q + h * 64, qg, 0.125f, nullptr, (const bf16_t*)Kl, Vl, 200,
                            (bf16_t*)(p->ws + WS_OB) + (size_t)m * 512 + h * 64, qs * 16, chunk, slope, sink);
        }
      } else {
        const int v = u - 512, kvh = v & 1, b = v >> 1, h = kvh * 4 + w;
        const float slope = exp2f(-(float)(h + 1)), sink = p->in[25][l * 8 + h];
        const float* kc = p->in[2] + ((size_t)l * 32 + b) * 128 * 128 + kvh * 64;
        const bf16_t* kb = P + (size_t)(TP + b * 64) * MIXC + C_SK + kvh * 64;
        const bf16_t* vt = (const bf16_t*)(p->ws + WS_VSS) + (size_t)(b * 2 + kvh) * 64 * 192;
        unsigned char* Kl = smem;
        bf16_t* Vl = (bf16_t*)(smem + 24576);
#pragma unroll 2
        for (int k = 0; k < 6; ++k) {
          const int idx = tid + k * 256, r = idx >> 3, c = idx & 7;
          u32x4 kv;
          if (r < 128) { const float* kp = kc + (size_t)r * 128 + c * 8; kv = __builtin_bit_cast(u32x4, cvt8(*(const f32x4*)kp, *(const f32x4*)(kp + 4))); }
          else kv = *(const u32x4*)(kb + (size_t)(r - 128) * MIXC + c * 8);
          *(u32x4*)(Kl + r * 128 + ((c ^ (r & 7)) * 16)) = kv;
          const int d = idx / 24, ch = idx % 24;
          *(u32x4*)(Vl + d * 200 + ch * 8) = *(const u32x4*)(vt + (size_t)d * 192 + ch * 8);
        }
        __syncthreads();
#pragma unroll 1
        for (int qs = 0; qs < 4; ++qs) {
          const int m = TP + b * 64 + qs * 16 + l15;
          attn16<64, 12, 3>(p, l, P + (size_t)m * MIXC + C_Q + h * 64, qg, 0.125f, nullptr, (const bf16_t*)Kl, Vl, 200,
                            (bf16_t*)(p->ws + WS_OB) + (size_t)m * 512 + h * 64, qs * 16, 2, slope, sink);
        }
      }
    } else {
      const int u = item - Q_REC_S - Q_SWA, h = u & 3, tile = u >> 2;
      const int m = tile * 64 + w * 16 + l15;
      const int bb = m < TP ? (m >> 12) : 4 + ((m - TP) >> 6);
      const float* kf = (bb < 4 ? p->out + O_MK_P + ((size_t)l * 4 + bb) * 256 * 512 : p->in[4] + ((size_t)l * 32 + (bb - 4)) * 256 * 512) + h * 128;
      const bf16_t* vt = (const bf16_t*)(p->ws + WS_VM) + (size_t)(bb * 4 + h) * 128 * 256;
#pragma unroll 4
      for (int k = 0; k < 16; ++k) {
        const int idx = tid + k * 256, d = idx >> 5, ch = idx & 31;
        *(u32x4*)(smem + d * 512 + ((ch ^ (d & 15)) * 16)) = *(const u32x4*)(vt + (size_t)d * 256 + ch * 8);
      }
      __syncthreads();
      attn16<128, 16, 4>(p, l, P + (size_t)m * MIXC + C_QM + h * 128, p->in[28] + l * 128, 0.08838834764831845f, kf, nullptr, (const bf16_t*)smem, 256,
                         (bf16_t*)(p->ws + WS_OM) + (size_t)m * 512 + h * 128, 0, 0, 0.f, 0.f);
    }
  }
  if ((blockIdx.x & 255) >= 128) {
    for (;;) {
      __syncthreads();
      if (tid == 0) *sitem = (int)atomicAdd(ctr + 8, 1u);
      __syncthreads();
      int u = *sitem;
      if (u >= 2304) break;
      u = __builtin_amdgcn_readfirstlane(u);
      gates_tile(p, l, (u >> 4) * 128, (u & 15) * 128, smem);
    }
  }
}

DI void phase_post(const PP p, int l, unsigned char* smem) {
  const bf16_t* P = (const bf16_t*)(p->ws + WS_P);
  const bf16_t* LIN = (const bf16_t*)(p->ws + WS_LIN);
  bf16_t* OA = (bf16_t*)(p->ws + WS_OA);
  const float* BON = (const float*)(p->ws + WS_BON);
  const float* lng = p->in[21] + l * 512;
  const float* lnb = p->in[22] + l * 512;
  const float* muv = p->in[12] + l * RC + C_V;
  for (int t = blockIdx.x; t < 144 * 4; t += gridDim.x) {
    const int m0 = (t >> 2) * 128, n0 = (t & 3) * 128;
    f32x4 acc[4][4];
    zero_acc<4, 4>(acc);
    gemm_acc<4, 4>(acc, LIN + (size_t)m0 * 256 + 128, 256, (const bf16_t*)(p->ws + WS_WG2) + (size_t)n0 * 128, 128, 128, smem);
    EPI_IDX(4, 4)
    __syncthreads();
    const int hh = (n0 + wn_ * 64) >> 6;
#pragma unroll
    for (int i = 0; i < 4; ++i) {
      const int m = mb_ + i * 16, tt = tok_t(m);
      float ov[4][4];
      float sm = 0.f;
#pragma unroll
      for (int j = 0; j < 4; ++j) {
        u32x2 v = *(const u32x2*)(OA + (size_t)m * 512 + nb_ + j * 16);
        ov[j][0] = lo16(v[0]); ov[j][1] = hi16(v[0]); ov[j][2] = lo16(v[1]); ov[j][3] = hi16(v[1]);
        sm += ov[j][0] + ov[j][1] + ov[j][2] + ov[j][3];
      }
      sm += __shfl_xor(sm, 16);
      sm += __shfl_xor(sm, 32);
      const float mean = sm * (1.f / 64.f);
      float vs = 0.f;
#pragma unroll
      for (int j = 0; j < 4; ++j)
#pragma unroll
        for (int r = 0; r < 4; ++r) { const float d = ov[j][r] - mean; vs += d * d; }
      vs += __shfl_xor(vs, 16);
      vs += __shfl_xor(vs, 32);
      const float rstd = rsqrtf(vs * (1.f / 64.f) + GN_EPS);
      const float bon = BON[(size_t)m * 8 + hh];
#pragma unroll
      for (int j = 0; j < 4; ++j) {
        const int n = nb_ + j * 16;
        u32x2 cv = *(const u32x2*)(P + (size_t)m * MIXC + C_V + n);
        float pv[4] = {lo16(cv[0]), hi16(cv[0]), lo16(cv[1]), hi16(cv[1])};
        float qv[4];
        if (tt > 0) {
          u32x2 pvv = *(const u32x2*)(P + (size_t)(m - 1) * MIXC + C_V + n);
          qv[0] = lo16(pvv[0]); qv[1] = hi16(pvv[0]); qv[2] = lo16(pvv[1]); qv[3] = hi16(pvv[1]);
        } else {
#pragma unroll
          for (int r = 0; r < 4; ++r) qv[r] = shift_in(p, l, m, C_V + n + r);
        }
        float res[4];
#pragma unroll
        for (int r = 0; r < 4; ++r) {
          const float vmix = pv[r] + (qv[r] - pv[r]) * muv[n + r];
          res[r] = ((ov[j][r] - mean) * rstd * lng[n + r] + lnb[n + r] + bon * vmix) * acc[i][j][r];
        }
        { u32x2 o_; o_[0] = pack2(res[0], res[1]); o_[1] = pack2(res[2], res[3]);
          *(u32x2*)(smem + (wm_ * 64 + i * 16 + l15_) * 272 + (wn_ * 64 + j * 16 + quad_ * 4) * 2) = o_; }
      }
    }
    tile_flush<4>(OA, 512, m0, n0, smem);
  }
}

DI void phase_gates(const PP p, int l, unsigned char* smem) {
  const int nt = 8, nb = 16;
  for (int t = blockIdx.x; t < 144 * nt; t += gridDim.x) gates_tile(p, l, (t / nt) * 128, (nb + t % nt) * 128, smem);
}
DI void phase_merge(const PP p, int l, unsigned char* smem) {
  const bf16_t* G = (const bf16_t*)(p->ws + WS_P);
  bf16_t* MG = (bf16_t*)(p->ws + WS_LD);
  for (int t = blockIdx.x; t < 144 * 16; t += gridDim.x) {
    const int m0 = (t >> 4) * 128, n0 = (t & 15) * 64;
    f32x4 mg[4][2];
    zero_acc<4, 2>(mg);
    EPI_IDX(4, 2)
#pragma unroll 1
    for (int br = 0; br < 3; ++br) {
      f32x4 ab[4][2];
      zero_acc<4, 2>(ab);
      gemm_acc<4, 2>(ab, (const bf16_t*)(p->ws + WS_OA + (size_t)br * 18874368) + (size_t)m0 * 512, 512,
                     (const bf16_t*)(p->ws + WS_WBR + (size_t)br * 1048576) + (size_t)n0 * 512, 512, 512, smem);
#pragma unroll
      for (int i = 0; i < 4; ++i)
#pragma unroll
        for (int j = 0; j < 2; ++j) {
          const bf16_t* gp = (br < 2) ? (const bf16_t*)p->out + (size_t)(mb_ + i * 16) * 2048 + br * 1024 + nb_ + j * 16
                                                : G + (size_t)(mb_ + i * 16) * MIXC + br * 1024 + nb_ + j * 16;
          const u32x2 g = *(const u32x2*)gp;
          mg[i][j][0] += lo16(g[0]) * ab[i][j][0];
          mg[i][j][1] += hi16(g[0]) * ab[i][j][1];
          mg[i][j][2] += lo16(g[1]) * ab[i][j][2];
          mg[i][j][3] += hi16(g[1]) * ab[i][j][3];
        }
      __builtin_amdgcn_sched_barrier(0);
    }
    u32x2 ov[4][2];
#pragma unroll
    for (int i = 0; i < 4; ++i)
#pragma unroll
      for (int j = 0; j < 2; ++j) {
        ov[i][j][0] = pack2(mg[i][j][0], mg[i][j][1]); ov[i][j][1] = pack2(mg[i][j][2], mg[i][j][3]);
      }
    store_tile<2>(ov, MG, 1024, m0, n0, smem);
  }
}

DI f32x4 resid4(const PP p, int l, int m, int n) {
  if (l == 0) return *(const f32x4*)(xrow(p, 0, m) + n);
  const u32x2 v = *(const u32x2*)((const bf16_t*)(p->ws + WS_XB) + (size_t)m * 1024 + n);
  return (f32x4){lo16(v[0]), hi16(v[0]), lo16(v[1]), hi16(v[1])};
}
DI void phase_out(const PP p, int l, unsigned char* smem) {
  const bf16_t* MG = (const bf16_t*)(p->ws + WS_LD);
  for (int t = blockIdx.x; t < 1024; t += gridDim.x) {
    const int m0 = (t >> 3) * 128, n0 = (t & 7) * 128;
    f32x4 acc[4][4];
    zero_acc<4, 4>(acc);
    gemm_acc<4, 4>(acc, MG + (size_t)m0 * 1024, 1024, (const bf16_t*)(p->ws + WS_WOUT) + (size_t)n0 * 1024, 1024, 1024, smem);
    EPI_IDX(4, 4)
#pragma unroll
    for (int i = 0; i < 4; ++i) {
      const int m = mb_ + i * 16;
#pragma unroll
      for (int j = 0; j < 4; ++j) {
        const int n = nb_ + j * 16;
        f32x4 xv = resid4(p, l, m, n);
        *(f32x4*)(p->out + (size_t)m * DM + n) = xv + acc[i][j];
      }
    }
  }
  for (int hb = blockIdx.x; hb < 256; hb += gridDim.x) {
    const int t = 1024 + (hb >> 1), m0 = (t >> 3) * 128, n0 = (t & 7) * 128 + (hb & 1) * 64;
    f32x4 acc[4][2];
    zero_acc<4, 2>(acc);
    gemm_acc<4, 2>(acc, MG + (size_t)m0 * 1024, 1024, (const bf16_t*)(p->ws + WS_WOUT) + (size_t)n0 * 1024, 1024, 1024, smem);
    EPI_IDX(4, 2)
#pragma unroll
    for (int i = 0; i < 4; ++i) {
      const int m = mb_ + i * 16;
#pragma unroll
      for (int j = 0; j < 2; ++j) {
        const int n = nb_ + j * 16;
        f32x4 xv = resid4(p, l, m, n);
        *(f32x4*)(p->out + (size_t)m * DM + n) = xv + acc[i][j];
      }
    }
  }
}

DI void phase_up_a(const PP p, int l, unsigned char* smem) {
  const float* rs2 = (const float*)(p->ws + WS_RS2);
  bf16_t* AIN = (bf16_t*)(p->ws + WS_P);
  for (int t = blockIdx.x; t < 144 * 22; t += gridDim.x) {
    const int m0 = (t / 22) * 128, n0 = (t % 22) * 128;
    f32x4 acc[4][4];
    zero_acc<4, 4>(acc);
    gemm_acc<4, 4>(acc, (const bf16_t*)(p->ws + WS_XB) + (size_t)m0 * 1024, 1024, (const bf16_t*)(p->ws + WS_WUP) + (size_t)n0 * 1024, 1024, 1024, smem);
    EPI_IDX(4, 4)
    u32x2 ov[4][4];
#pragma unroll
    for (int i = 0; i < 4; ++i) {
      const int m = mb_ + i * 16, tt = tok_t(m), T = m < TP ? 4096 : 64;
      const float rs = rs2[m];
#pragma unroll
      for (int j = 0; j < 4; ++j) {
        const int n = nb_ + j * 16;
        f32x4 v = acc[i][j] * rs;
        u32x2 o; o[0] = pack2(v[0], v[1]); o[1] = pack2(v[2], v[3]);
        ov[i][j] = o;
        if (tt >= T - 2) {
          float* co = m < TP ? p->out + O_CV_P + (((size_t)l * 4 + (m >> 12)) * 2 + (tt - (T - 2))) * DFF + n
                             : p->out + O_CV_S + (((size_t)l * 32 + ((m - TP) >> 6)) * 2 + (tt - (T - 2))) * DFF + n;
          *(f32x4*)co = v;
        }
      }
    }
    store_tile<4>(ov, AIN, DFF, m0, n0, smem);
  }
}
DI float gelu_tanh(float x) {
  const float u2 = 1.5957691216057308f * (x + 0.044715f * x * x * x);
  return x * __builtin_amdgcn_rcpf(1.f + __expf(-u2));
}
DI void phase_up_u(const PP p, int l, unsigned char* smem) {
  const float* rs2 = (const float*)(p->ws + WS_RS2);
  const bf16_t* AIN = (const bf16_t*)(p->ws + WS_P);
  bf16_t* ACT = (bf16_t*)(p->ws + WS_R);
  const float* cw = p->in[34] + (size_t)l * 3 * DFF;
  const float* cb = p->in[35] + (size_t)l * DFF;
  for (int t = blockIdx.x; t < 144 * 22; t += gridDim.x) {
    const int m0 = (t / 22) * 128, n0 = (t % 22) * 128;
    f32x4 acc[4][4];
    zero_acc<4, 4>(acc);
    gemm_acc<4, 4>(acc, (const bf16_t*)(p->ws + WS_XB) + (size_t)m0 * 1024, 1024, (const bf16_t*)(p->ws + WS_WUP) + (size_t)(DFF + n0) * 1024, 1024, 1024, smem);
    EPI_IDX(4, 4)
    __syncthreads();
#pragma unroll 3
    for (int k = 0; k < 9; ++k) {
      const int idx = tid_ + k * 256, rr = idx >> 4, ch = idx & 15, mr = m0 - 2 + rr;
      if (rr < 130 && mr >= 0) *(u32x4*)(smem + rr * 272 + ch * 16) = *(const u32x4*)(AIN + (size_t)mr * DFF + n0 + ch * 8);
    }
    __syncthreads();
    u32x2 ov[4][4];
#pragma unroll
    for (int i = 0; i < 4; ++i) {
      const int m = mb_ + i * 16, tt = tok_t(m);
      const float rs = rs2[m];
#pragma unroll
      for (int j = 0; j < 4; ++j) {
        const int n = nb_ + j * 16;
        f32x4 c = *(const f32x4*)(cb + n);
#pragma unroll
        for (int jj = 0; jj < 3; ++jj) {
          const int ts = tt - 2 + jj;
          f32x4 av;
          if (ts >= 0) {
            u32x2 v = *(const u32x2*)(smem + (m - m0 + jj) * 272 + (n - n0) * 2);
            av = (f32x4){lo16(v[0]), hi16(v[0]), lo16(v[1]), hi16(v[1])};
          } else if (m >= TP) {
            av = *(const f32x4*)(p->in[8] + (((size_t)l * 32 + ((m - TP) >> 6)) * 2 + (ts + 2)) * DFF + n);
          } else {
            av = (f32x4){0.f, 0.f, 0.f, 0.f};
          }
          c += av * *(const f32x4*)(cw + jj * DFF + n);
        }
        f32x4 u = acc[i][j] * rs;
        u32x2 o; o[0] = pack2(gelu_tanh(c[0]) * u[0], gelu_tanh(c[1]) * u[1]); o[1] = pack2(gelu_tanh(c[2]) * u[2], gelu_tanh(c[3]) * u[3]);
        ov[i][j] = o;
      }
    }
    store_tile<4>(ov, ACT, DFF, m0, n0, smem);
  }
}
DI void phase_down(const PP p, int l, unsigned char* smem) {
  const bf16_t* ACT = (const bf16_t*)(p->ws + WS_R);
  for (int t = blockIdx.x; t < 1024; t += gridDim.x) {
    const int m0 = (t >> 3) * 128, n0 = (t & 7) * 128;
    f32x4 acc[4][4];
    zero_acc<4, 4>(acc);
    gemm_acc<4, 4>(acc, ACT + (size_t)m0 * DFF, DFF, (const bf16_t*)(p->ws + WS_WDN) + (size_t)n0 * DFF, DFF, DFF, smem);
    EPI_IDX(4, 4)
#pragma unroll
    for (int i = 0; i < 4; ++i) {
      const int m = mb_ + i * 16;
#pragma unroll
      for (int j = 0; j < 4; ++j) {
        float* y = p->out + (size_t)m * DM + nb_ + j * 16;
        *(f32x4*)y = *(const f32x4*)y + acc[i][j];
      }
    }
  }
  for (int hb = blockIdx.x; hb < 256; hb += gridDim.x) {
    const int t = 1024 + (hb >> 1), m0 = (t >> 3) * 128, n0 = (t & 7) * 128 + (hb & 1) * 64;
    f32x4 acc[4][2];
    zero_acc<4, 2>(acc);
    gemm_acc<4, 2>(acc, ACT + (size_t)m0 * DFF, DFF, (const bf16_t*)(p->ws + WS_WDN) + (size_t)n0 * DFF, DFF, DFF, smem);
    EPI_IDX(4, 2)
#pragma unroll
    for (int i = 0; i < 4; ++i) {
      const int m = mb_ + i * 16;
#pragma unroll
      for (int j = 0; j < 2; ++j) {
        float* y = p->out + (size_t)m * DM + nb_ + j * 16;
        *(f32x4*)y = *(const f32x4*)y + acc[i][j];
      }
    }
  }
}


#define XB_TMO      128
#define XB_XCNT(j)  (256  + 64 * (j))
#define XB_XSUB(j)  (1280 + 64 * (j))
#define XB_XGEN(j)  (2304 + 64 * (j))
#define XB_TOP      3328
#define XB_TOPGEN   3392
#define XCD_BAR_WORDS 3456
#define XB_SPIN_CAP (1u << 18)
#define LAS __attribute__((address_space(3)))
DI unsigned xb_ld(unsigned* p) { return __hip_atomic_load(p, __ATOMIC_RELAXED, __HIP_MEMORY_SCOPE_AGENT); }
DI unsigned xb_add(unsigned* p, unsigned v) { return __hip_atomic_fetch_add(p, v, __ATOMIC_RELAXED, __HIP_MEMORY_SCOPE_AGENT); }
DI unsigned xb_xcc_id() { return (unsigned)__builtin_amdgcn_s_getreg((3 << 11) | 20) & 0xFu; }
#define XB_SPIN(cond, bar) do { unsigned _sp = 0; while (cond) { __builtin_amdgcn_s_sleep(1); \
    if ((++_sp & 255u) == 0u) { if (xb_ld(&(bar)[XB_TMO])) break; if (_sp > XB_SPIN_CAP) { atomicAdd(&(bar)[XB_TMO], 1u); break; } } } } while (0)
struct XcdBarrier { unsigned* bar; unsigned x; volatile LAS unsigned* st; };
DI XcdBarrier xcd_barrier_post(unsigned* bar, volatile LAS unsigned* st) {
  XcdBarrier b; b.bar = bar; b.x = xb_xcc_id(); b.st = st;
  if (threadIdx.x == 0) (void)xb_add(&bar[XB_XCNT(b.x)], 1u);
  return b;
}
DI void xcd_barrier_complete(unsigned* bar, unsigned x, unsigned& nloc, unsigned& nx) {
  const unsigned G = gridDim.x * gridDim.y * gridDim.z;
  unsigned sum, cnt, mine, sp = 0u;
  for (;;) {
    sum = 0u; cnt = 0u; mine = 0u;
#pragma unroll
    for (unsigned j = 0; j < 16; ++j) { const unsigned c = xb_ld(&bar[XB_XCNT(j)]); sum += c; cnt += (c > 0u) ? 1u : 0u; mine = (j == x) ? c : mine; }
    if (sum == G) break;
    __builtin_amdgcn_s_sleep(1);
    if ((++sp & 255u) == 0u) { if (xb_ld(&bar[XB_TMO])) break; if (sp > XB_SPIN_CAP) { atomicAdd(&bar[XB_TMO], 1u); break; } }
  }
  nloc = mine > 0u ? mine : 1u; nx = cnt > 0u ? cnt : 1u;
}
DI void xcd_barrier(const XcdBarrier& b) {
  asm volatile("s_waitcnt vmcnt(0)" ::: "memory");
  __syncthreads();
  if (threadIdx.x == 0) {
    unsigned* bar = b.bar;
    __builtin_amdgcn_s_waitcnt(0);
    unsigned nloc = b.st[0], nx = b.st[1];
    if (nloc == 0u) { xcd_barrier_complete(bar, b.x, nloc, nx); b.st[0] = nloc; b.st[1] = nx; }
    const unsigned old = xb_add(&bar[XB_XSUB(b.x)], 1u);
    const unsigned gen = old / nloc;
    if (old + 1u == (gen + 1u) * nloc) {
      __builtin_amdgcn_fence(__ATOMIC_RELEASE, "agent");
      asm volatile("s_waitcnt vmcnt(0)" ::: "memory");
      const unsigned og = xb_add(&bar[XB_TOP], 1u);
      const unsigned tg = og / nx;
      if (og + 1u == (tg + 1u) * nx) xb_add(&bar[XB_TOPGEN], 1u);
      else XB_SPIN(xb_ld(&bar[XB_TOPGEN]) == tg, bar);
      __builtin_amdgcn_fence(__ATOMIC_ACQUIRE, "agent");
      xb_add(&bar[XB_XGEN(b.x)], 1u);
      asm volatile("s_waitcnt vmcnt(0)" ::: "memory");
    } else {
      XB_SPIN(xb_ld(&bar[XB_XGEN(b.x)]) == gen, bar);
      __builtin_amdgcn_fence(__ATOMIC_ACQUIRE, "agent");
      asm volatile("s_waitcnt vmcnt(0)" ::: "memory");
    }
  }
  __syncthreads();
}

__global__ void __launch_bounds__(256, 2) mega(Params p_arg) {
  __shared__ __attribute__((aligned(16))) unsigned char smem[65536 + 64];
  cg::grid_group grid = cg::this_grid();
  __shared__ uint4 xb_words;
  if (threadIdx.x == 0) xb_words = make_uint4(0u, 0u, 0u, 0u);
  __syncthreads();
  const XcdBarrier xb = xcd_barrier_post((unsigned*)(p_arg.ws + WS_BAR), (volatile LAS unsigned*)&xb_words);
  if (p_arg.out == nullptr) grid.sync();
#pragma unroll 1
  for (int ph = 0; ph < 26; ++ph) {
    int l = ph >= 13 ? 1 : 0;
    const __attribute__((address_space(4))) Params* kp = (const __attribute__((address_space(4))) Params*)__builtin_amdgcn_kernarg_segment_ptr();
    l = __builtin_amdgcn_readfirstlane(l);
    asm volatile("" : "+s"(kp));
    asm volatile("" : "+s"(l));
    const PP p = kp;
    switch (ph - l * 13) {
      case 0: phase_convert(p, l, smem); break;
      case 1: phase_gemm_in(p, l, smem); break;
      case 2: phase_prep(p, l); break;
      case 3: phase_lora(p, l, smem); break;
      case 4: phase_mixers(p, l, smem, ph); break;
      case 5: phase_post(p, l, smem); phase_gates(p, l, smem); break;
      case 6: break;
      case 7: phase_merge(p, l, smem); break;
      case 8: phase_out(p, l, smem); break;
      case 9: phase_stats2(p); break;
      case 10: phase_up_a(p, l, smem); break;
      case 11: phase_up_u(p, l, smem); break;
      default: phase_down(p, l, smem); break;
    }
    if (ph + 1 < 26 && ph != 6 && ph != 19) xcd_barrier(xb);
  }
}

extern "C" void kernel_launch(void* const* d_in, const int* in_sizes, int n_in, void* d_out, int out_size, void* d_ws, size_t ws_size,
                              hipStream_t stream) {
  static int grid_blocks = 0;
  if (!grid_blocks) {
    int dev = 0, cus = 0, per_cu = 0;
    (void)hipGetDevice(&dev);
    (void)hipDeviceGetAttribute(&cus, hipDeviceAttributeMultiprocessorCount, dev);
    (void)hipOccupancyMaxActiveBlocksPerMultiprocessor(&per_cu, mega, 256, 0);
    if (per_cu > 2) per_cu = 2;
    if (per_cu < 1) per_cu = 1;
    grid_blocks = cus * per_cu;
  }
  if (ws_size < WS_END) fprintf(stderr, "workspace too small: %zu < %zu\n", ws_size, (size_t)WS_END);
  Params p{};
  for (int i = 0; i < 37; ++i) p.in[i] = (const float*)d_in[i];
  p.out = (float*)d_out;
  p.ws = (unsigned char*)d_ws;
  (void)hipMemsetAsync(d_ws, 0, 4096 + 16384, stream);
  void* args[] = {&p};
  hipError_t e = hipLaunchCooperativeKernel((void*)mega, dim3(grid_blocks), dim3(256), args, 0, stream);
  if (e != hipSuccess) fprintf(stderr, "coop launch failed: %s\n", hipGetErrorString(e));
}
```

```cpp
#include <hip/hip_runtime.h>
#include <hip/hip_cooperative_groups.h>
#include <cstdio>
namespace cg = cooperative_groups;

typedef unsigned short bf16_t;
typedef short bf16x8 __attribute__((ext_vector_type(8)));
typedef float f32x4 __attribute__((ext_vector_type(4)));
typedef unsigned u32x4 __attribute__((ext_vector_type(4)));
typedef unsigned u32x2 __attribute__((ext_vector_type(2)));
#define DI __device__ __forceinline__

constexpr int DM = 1024, TP = 16384, TS = 2048, MT = 18432;
constexpr int RC = 1792, MIXC = 3072, DFF = 2816;
constexpr int C_R = 0, C_K = 512, C_V = 1024, C_X = 1536, C_Q = 1792, C_SK = 2304, C_SV = 2432, C_QM = 2560;
constexpr float RMS_EPS = 1e-6f, GN_EPS = 64e-5f;

constexpr size_t O_Y = 0;
constexpr size_t O_SWK_P = (size_t)MT * DM;
constexpr size_t O_SWV_P = O_SWK_P + 131072;
constexpr size_t O_MK_P = O_SWV_P + 131072;
constexpr size_t O_MV_P = O_MK_P + 1048576;
constexpr size_t O_RW_P = O_MV_P + 1048576;
constexpr size_t O_SH_P = O_RW_P + 262144;
constexpr size_t O_CV_P = O_SH_P + 14336;
constexpr size_t O_SWK_S = O_CV_P + 45056;
constexpr size_t O_SWV_S = O_SWK_S + 1048576;
constexpr size_t O_RW_S = O_SWV_S + 1048576;
constexpr size_t O_SH_S = O_RW_S + 2097152;
constexpr size_t O_CV_S = O_SH_S + 114688;

constexpr size_t WS_CTR = 0;
constexpr size_t WS_BAR = 4096;
constexpr size_t WS_RS1 = 4096 + 16384;
constexpr size_t WS_RS2 = WS_RS1 + 73728;
constexpr size_t WS_RSM = WS_RS2 + 73728;
constexpr size_t WS_BON = WS_RSM + 4096;
constexpr size_t WS_WIN = WS_BON + 589824;
constexpr size_t WS_WUP = WS_WIN + 12582912;
constexpr size_t WS_WDN = WS_WUP + 11534336;
constexpr size_t WS_WBR = WS_WDN + 5767168;
constexpr size_t WS_WOUT = WS_WBR + 3145728;
constexpr size_t WS_WMKV = WS_WOUT + 2097152;
constexpr size_t WS_WW2 = WS_WMKV + 2097152;
constexpr size_t WS_WA2 = WS_WW2 + 65536;
constexpr size_t WS_WG2 = WS_WA2 + 65536;
constexpr size_t WS_P = WS_WG2 + 131072;
constexpr size_t WS_R = WS_P + 113246208;
constexpr size_t WS_LD = WS_R;
constexpr size_t WS_AA = WS_LD + 18874368;
constexpr size_t WS_LIN = WS_AA + 18874368;
constexpr size_t WS_OA = WS_LIN + 9437184;
constexpr size_t WS_OB = WS_OA + 18874368;
constexpr size_t WS_OM = WS_OB + 18874368;
constexpr size_t WS_VSP = WS_R + 103809024;
constexpr int VSP_LD = 4224;
constexpr size_t WS_VSS = WS_VSP + (size_t)4 * 2 * 64 * VSP_LD * 2;
constexpr size_t WS_VM = WS_VSS + (size_t)32 * 2 * 64 * 192 * 2;
constexpr size_t WS_XB = WS_VM + (size_t)36 * 4 * 128 * 256 * 2;
constexpr size_t WS_END = WS_XB + (size_t)(MT + 1024) * 1024 * 2;

struct Params {
  const float* in[37];
  float* out;
  unsigned char* ws;
};
typedef const __attribute__((address_space(4))) Params* PP;

DI int tidx() { int t = __builtin_amdgcn_workitem_id_x(); asm volatile("" : "+v"(t)); return t; }
DI float bf2f(bf16_t h) { return __uint_as_float(((unsigned)h) << 16); }
typedef float f32x2 __attribute__((ext_vector_type(2)));
typedef __bf16 bf16v2 __attribute__((ext_vector_type(2)));
DI unsigned pack2(float lo, float hi) { f32x2 v = {lo, hi}; bf16v2 b = __builtin_convertvector(v, bf16v2); return __builtin_bit_cast(unsigned, b); }
DI bf16_t f2bf(float x) { return (bf16_t)(pack2(x, 0.f) & 0xffffu); }
DI float lo16(unsigned u) { return __uint_as_float(u << 16); }
DI float hi16(unsigned u) { return __uint_as_float(u & 0xffff0000u); }
DI float sigmoidf_(float x) { return __builtin_amdgcn_rcpf(1.f + __expf(-x)); }
DI int tok_t(int m) { return m < TP ? (m & 4095) : (m & 63); }
DI int tok_b(int m) { return m < TP ? (m >> 12) : ((m - TP) >> 6); }
DI const float* xrow(const PP p, int l, int m) {
  return l == 0 ? (m < TP ? p->in[0] + (size_t)m * DM : p->in[1] + (size_t)(m - TP) * DM) : p->out + (size_t)m * DM;
}
DI float shift_in(const PP p, int l, int m, int c) {
  return m < TP ? 0.f : p->in[7][((size_t)l * 32 + ((m - TP) >> 6)) * RC + c];
}
DI float wave_sum(float v) {
#pragma unroll
  for (int o = 32; o > 0; o >>= 1) v += __shfl_xor(v, o);
  return v;
}
template <int CTRL> DI float dpp_add(float x) {
  return x + __int_as_float(__builtin_amdgcn_update_dpp(0, __float_as_int(x), CTRL, 0xf, 0xf, true));
}
DI float allreduce16(float x) {
  x = dpp_add<0xB1>(x);
  x = dpp_add<0x4E>(x);
  x = dpp_add<0x141>(x);
  x = dpp_add<0x140>(x);
  return x;
}
DI bf16x8 cvt8(f32x4 a, f32x4 b) {
  u32x4 r; r[0] = pack2(a[0], a[1]); r[1] = pack2(a[2], a[3]); r[2] = pack2(b[0], b[1]); r[3] = pack2(b[2], b[3]);
  return __builtin_bit_cast(bf16x8, r);
}
#define MFMA16(a, b, c) __builtin_amdgcn_mfma_f32_16x16x32_bf16((a), (b), (c), 0, 0, 0)

constexpr int LSTR = 144;
typedef const void __attribute__((address_space(1)))* gptr_t;
typedef void __attribute__((address_space(3)))* lptr_t;
template <int MI, int NJ>
DI void gemm_acc(f32x4 (&acc)[MI][NJ], const bf16_t* Ap, int lda, const bf16_t* Bt, int ldb, int K, unsigned char* smem) {
  const int tid = tidx(), lane = tid & 63, w = tid >> 6, wm = w >> 1, wn = w & 1, l15 = lane & 15, quad = lane >> 4;
  constexpr int AROWS = MI * 32, BROWS = NJ * 32, STAGE = (AROWS + BROWS) * 128;
  const int nk = K >> 6;
  const int r_in = lane >> 3, ch = (lane & 7) ^ r_in;
  const bf16_t* ag = Ap + (size_t)(w * 8 + r_in) * lda + ch * 8;
  const bf16_t* bg = Bt + (size_t)(w * 8 + r_in) * ldb + ch * 8;
  unsigned char* dma = smem + w * 1024;
  auto issue = [&](int kt, int st) {
    unsigned char* sa = dma + st * STAGE;
#pragma unroll
    for (int i = 0; i < MI; ++i)
      __builtin_amdgcn_global_load_lds((gptr_t)(ag + (size_t)(i * 32) * lda + kt * 64), (lptr_t)(sa + i * 4096), 16, 0, 0);
#pragma unroll
    for (int i = 0; i < NJ; ++i)
      __builtin_amdgcn_global_load_lds((gptr_t)(bg + (size_t)(i * 32) * ldb + kt * 64), (lptr_t)(sa + AROWS * 128 + i * 4096), 16, 0, 0);
  };
  const int ro0 = (quad ^ (l15 & 7)) * 16, ro1 = ro0 ^ 64;
  const unsigned char* rA = smem + (wm * MI * 16 + l15) * 128;
  const unsigned char* rB = smem + AROWS * 128 + (wn * NJ * 16 + l15) * 128;
  __syncthreads();
  issue(0, 0);
  for (int kt = 0; kt < nk; ++kt) {
    asm volatile("s_waitcnt vmcnt(0)" ::: "memory");
    __syncthreads();
    const int so = (kt & 1) * STAGE;
    bf16x8 fb0[NJ], fa0[MI], fb1[NJ], fa1[MI];
#pragma unroll
    for (int j = 0; j < NJ; ++j) fb0[j] = *(const bf16x8*)(rB + so + j * 2048 + ro0);
#pragma unroll
    for (int i = 0; i < MI; ++i) fa0[i] = *(const bf16x8*)(rA + so + i * 2048 + ro0);
#pragma unroll
    for (int j = 0; j < NJ; ++j) fb1[j] = *(const bf16x8*)(rB + so + j * 2048 + ro1);
#pragma unroll
    for (int i = 0; i < MI; ++i) fa1[i] = *(const bf16x8*)(rA + so + i * 2048 + ro1);
    __builtin_amdgcn_sched_barrier(0);
    if (kt + 1 < nk) issue(kt + 1, (kt + 1) & 1);
    __builtin_amdgcn_sched_barrier(0);
#pragma unroll
    for (int i = 0; i < MI; ++i)
#pragma unroll
      for (int j = 0; j < NJ; ++j) acc[i][j] = MFMA16(fb0[j], fa0[i], acc[i][j]);
#pragma unroll
    for (int i = 0; i < MI; ++i)
#pragma unroll
      for (int j = 0; j < NJ; ++j) acc[i][j] = MFMA16(fb1[j], fa1[i], acc[i][j]);
  }
}
template <int MI, int NJ> DI void zero_acc(f32x4 (&acc)[MI][NJ]) {
#pragma unroll
  for (int i = 0; i < MI; ++i)
#pragma unroll
    for (int j = 0; j < NJ; ++j) acc[i][j] = (f32x4){0.f, 0.f, 0.f, 0.f};
}
#define EPI_IDX(MI_, NJ_)                                                                         \
  const int tid_ = tidx(), lane_ = tid_ & 63, w_ = tid_ >> 6, wm_ = w_ >> 1, wn_ = w_ & 1;         \
  const int l15_ = lane_ & 15, quad_ = lane_ >> 4;                                                 \
  const int mb_ = m0 + wm_ * (MI_) * 16 + l15_, nb_ = n0 + wn_ * (NJ_) * 16 + quad_ * 4;

template <int NJ>
DI void store_tile(const u32x2 (&ov)[4][NJ], bf16_t* dst, size_t ld, int m0, int n0, unsigned char* smem) {
  const int tid = tidx(), lane = tid & 63, w = tid >> 6, wm = w >> 1, wn = w & 1, l15 = lane & 15, quad = lane >> 4;
  constexpr int RS = NJ * 64 + 16;
  __syncthreads();
#pragma unroll
  for (int i = 0; i < 4; ++i)
#pragma unroll
    for (int j = 0; j < NJ; ++j)
      *(u32x2*)(smem + (wm * 64 + i * 16 + l15) * RS + (wn * NJ * 16 + j * 16 + quad * 4) * 2) = ov[i][j];
  __syncthreads();
  constexpr int CPR = NJ * 4;
#pragma unroll
  for (int k = 0; k < (128 * CPR) / 256; ++k) {
    const int c = tid + k * 256, row = c / CPR, ch = c % CPR;
    const u32x4 v = *(const u32x4*)(smem + row * RS + ch * 16);
    *(u32x4*)(dst + (size_t)(m0 + row) * ld + n0 + ch * 8) = v;
  }
}

template <int NJ>
DI void tile_flush(bf16_t* dst, size_t ld, int m0, int n0, unsigned char* smem) {
  const int tid = tidx();
  constexpr int RS = NJ * 64 + 16, CPR = NJ * 4;
  __syncthreads();
#pragma unroll
  for (int k = 0; k < (128 * CPR) / 256; ++k) {
    const int c = tid + k * 256, row = c / CPR, ch = c % CPR;
    const u32x4 v = *(const u32x4*)(smem + row * RS + ch * 16);
    *(u32x4*)(dst + (size_t)(m0 + row) * ld + n0 + ch * 8) = v;
  }
}

DI bool conv_desc(const PP p, int l, int t, const float*& src, bf16_t*& dst, int& K, int& N, const float*& sc, int& lt) {
  int base = 0;
#define MAT(SRC, DST, KK, NN, SC)                                                               \
  {                                                                                             \
    const int nt = ((KK) / 64) * ((NN) / 64);                                                   \
    if (t < base + nt) { src = (SRC); dst = (bf16_t*)(p->ws + (DST)); K = (KK); N = (NN); sc = (SC); lt = t - base; return true; } \
    base += nt;                                                                                 \
  }
  MAT(p->in[11] + (size_t)l * 1024 * 6144, WS_WIN, 1024, 6144, p->in[10] + l * 1024)
  MAT(p->in[33] + (size_t)l * 1024 * 5632, WS_WUP, 1024, 5632, p->in[32] + l * 1024)
  MAT(p->in[36] + (size_t)l * 2816 * 1024, WS_WDN, 2816, 1024, nullptr)
  MAT(p->in[30] + (size_t)(l * 3 + 0) * 512 * 1024, WS_WBR, 512, 1024, nullptr)
  MAT(p->in[30] + (size_t)(l * 3 + 1) * 512 * 1024, WS_WBR + 1048576, 512, 1024, nullptr)
  MAT(p->in[30] + (size_t)(l * 3 + 2) * 512 * 1024, WS_WBR + 2097152, 512, 1024, nullptr)
  MAT(p->in[31] + (size_t)l * 1024 * 1024, WS_WOUT, 1024, 1024, nullptr)
  MAT(p->in[27] + (size_t)l * 1024 * 1024, WS_WMKV, 1024, 1024, p->in[26] + l * 1024)
  MAT(p->in[14] + (size_t)l * 64 * 512, WS_WW2, 64, 512, nullptr)
  MAT(p->in[16] + (size_t)l * 64 * 512, WS_WA2, 64, 512, nullptr)
  MAT(p->in[17] + (size_t)l * 128 * 512, WS_WG2, 128, 512, nullptr)
#undef MAT
  return false;
}
constexpr int CONV_TILES = 16 * 96 + 16 * 88 + 44 * 16 + 3 * 8 * 16 + 256 + 256 + 8 + 8 + 16;

DI void row_stats3(const float* s0, const float* s1, const float* s2, float* d0, float* d1, float* d2, bf16_t* x0, bf16_t* x1, bf16_t* x2, int lane) {
  f32x4 v[3][4];
#pragma unroll
  for (int i = 0; i < 4; ++i) {
    v[0][i] = *(const f32x4*)(s0 + (i * 64 + lane) * 4);
    if (s1) v[1][i] = *(const f32x4*)(s1 + (i * 64 + lane) * 4);
    if (s2) v[2][i] = *(const f32x4*)(s2 + (i * 64 + lane) * 4);
  }
  const float* sp[3] = {s0, s1, s2};
  float* dp[3] = {d0, d1, d2};
  bf16_t* xp[3] = {x0, x1, x2};
#pragma unroll
  for (int r = 0; r < 3; ++r) {
    if (!sp[r]) continue;
    float ss = 0.f;
#pragma unroll
    for (int i = 0; i < 4; ++i) {
      const f32x4 a = v[r][i];
      ss += a[0] * a[0] + a[1] * a[1] + a[2] * a[2] + a[3] * a[3];
      u32x2 o; o[0] = pack2(a[0], a[1]); o[1] = pack2(a[2], a[3]);
      *(u32x2*)(xp[r] + (i * 64 + lane) * 4) = o;
    }
    ss = wave_sum(ss);
    if (lane == 0) *dp[r] = rsqrtf(ss * (1.f / 1024.f) + RMS_EPS);
  }
}

DI void phase_convert(const PP p, int l, unsigned char* smem) {
  float* lds = (float*)smem;
  const int tid = tidx();
  {
    const float* src; bf16_t* dst; int K, N, lt; const float* sc;
    f32x4 v[4];
    float sv[4];
    int t = blockIdx.x, k0 = 0, n0 = 0;
    auto fetch = [&](int tt) {
      conv_desc(p, l, tt, src, dst, K, N, sc, lt);
      const int ntn = N >> 6;
      k0 = (lt / ntn) * 64; n0 = (lt % ntn) * 64;
#pragma unroll
      for (int ps = 0; ps < 4; ++ps) {
        const int r = ps * 16 + (tid >> 4), c = (tid & 15) * 4;
        v[ps] = *(const f32x4*)(src + (size_t)(k0 + r) * N + n0 + c);
        sv[ps] = sc ? sc[k0 + r] : 1.f;
      }
    };
    if (t < CONV_TILES) fetch(t);
    while (t < CONV_TILES) {
      __syncthreads();
#pragma unroll
      for (int ps = 0; ps < 4; ++ps) {
        const int r = ps * 16 + (tid >> 4), c = (tid & 15) * 4;
        const float s = sv[ps];
        lds[r * 65 + c] = v[ps][0] * s; lds[r * 65 + c + 1] = v[ps][1] * s; lds[r * 65 + c + 2] = v[ps][2] * s; lds[r * 65 + c + 3] = v[ps][3] * s;
      }
      __syncthreads();
      bf16_t* dcur = dst; const int Kc = K, k0c = k0, n0c = n0;
      const int tn = t + gridDim.x;
      if (tn < CONV_TILES) fetch(tn);
#pragma unroll
      for (int e = 0; e < 2; ++e) {
        const int idx = tid + e * 256, n = idx >> 3, kg = idx & 7;
        u32x4 o;
#pragma unroll
        for (int i = 0; i < 4; ++i) o[i] = pack2(lds[(kg * 8 + 2 * i) * 65 + n], lds[(kg * 8 + 2 * i + 1) * 65 + n]);
        *(u32x4*)(dcur + (size_t)(n0c + n) * Kc + k0c + kg * 8) = o;
      }
      t = tn;
    }
  }
  const int lane = tid & 63, gw = blockIdx.x * 4 + (tid >> 6), nw = gridDim.x * 4;
  float* rs1 = (float*)(p->ws + WS_RS1);
  float* rsm = (float*)(p->ws + WS_RSM);
  bf16_t* XB = (bf16_t*)(p->ws + WS_XB);
  auto srcrow = [&](int row) -> const float* { return row >= MT + 1024 ? nullptr : (row < MT ? xrow(p, l, row) : p->in[9] + (size_t)(row - MT) * 1024); };
  auto dstrow = [&](int row) -> float* { return row < MT ? rs1 + row : rsm + (row - MT); };
  for (int row = gw; row < MT + 1024; row += 3 * nw)
    row_stats3(srcrow(row), srcrow(row + nw), srcrow(row + 2 * nw), dstrow(row), dstrow(row + nw), dstrow(row + 2 * nw),
               XB + (size_t)row * 1024, XB + (size_t)(row + nw) * 1024, XB + (size_t)(row + 2 * nw) * 1024, lane);
}

DI void phase_stats2(const PP p) {
  const int tid = tidx(), lane = tid & 63, gw = blockIdx.x * 4 + (tid >> 6), nw = gridDim.x * 4;
  float* rs2 = (float*)(p->ws + WS_RS2);
  bf16_t* XB = (bf16_t*)(p->ws + WS_XB);
  auto srcrow = [&](int row) -> const float* { return row >= MT ? nullptr : p->out + (size_t)row * DM; };
  for (int row = gw; row < MT; row += 3 * nw)
    row_stats3(srcrow(row), srcrow(row + nw), srcrow(row + 2 * nw), rs2 + row, rs2 + row + nw, rs2 + row + 2 * nw,
               XB + (size_t)row * 1024, XB + (size_t)(row + nw) * 1024, XB + (size_t)(row + 2 * nw) * 1024, lane);
}

DI void phase_gemm_in(const PP p, int l, unsigned char* smem) {
  bf16_t* P = (bf16_t*)(p->ws + WS_P);
  const float* rs1 = (const float*)(p->ws + WS_RS1);
  const float* rsm = (const float*)(p->ws + WS_RSM);
  const int NT1 = 144 * 24;
  for (int t = blockIdx.x; t < NT1 + 64; t += gridDim.x) {
    f32x4 acc[4][4];
    zero_acc<4, 4>(acc);
    if (t < NT1) {
      const int m0 = (t / 24) * 128, n0 = (t % 24) * 128;
      gemm_acc<4, 4>(acc, (const bf16_t*)(p->ws + WS_XB) + (size_t)m0 * 1024, 1024, (const bf16_t*)(p->ws + WS_WIN) + (size_t)n0 * 1024, 1024, 1024, smem);
      EPI_IDX(4, 4)
      u32x2 ov[4][4];
#pragma unroll
      for (int i = 0; i < 4; ++i) {
        const int m = mb_ + i * 16;
        const float rs = rs1[m];
        const int t_ = tok_t(m);
        const bool last = m < TP ? (t_ == 4095) : (t_ == 63);
#pragma unroll
        for (int j = 0; j < 4; ++j) {
          const int n = nb_ + j * 16;
          f32x4 v = acc[i][j] * rs;
          u32x2 o; o[0] = pack2(v[0], v[1]); o[1] = pack2(v[2], v[3]);
          ov[i][j] = o;
          if (last && n < RC) {
            float* so = m < TP ? p->out + O_SH_P + ((size_t)l * 4 + (m >> 12)) * RC + n : p->out + O_SH_S + ((size_t)l * 32 + ((m - TP) >> 6)) * RC + n;
            *(f32x4*)so = v;
          }
        }
      }
      store_tile<4>(ov, P, MIXC, m0, n0, smem);
    } else {
      const int tt = t - NT1, m0 = (tt >> 3) * 128, n0 = (tt & 7) * 128;
      gemm_acc<4, 4>(acc, (const bf16_t*)(p->ws + WS_XB) + (size_t)(MT + m0) * 1024, 1024, (const bf16_t*)(p->ws + WS_WMKV) + (size_t)n0 * 1024, 1024, 1024, smem);
      EPI_IDX(4, 4)
#pragma unroll
      for (int i = 0; i < 4; ++i) {
        const int m = mb_ + i * 16;
        const float rs = rsm[m];
#pragma unroll
        for (int j = 0; j < 4; ++j) {
          const int n = nb_ + j * 16;
          f32x4 v = acc[i][j] * rs;
          float* dst = n < 512 ? p->out + O_MK_P + ((size_t)l * 1024 + m) * 512 + n : p->out + O_MV_P + ((size_t)l * 1024 + m) * 512 + (n - 512);
          *(f32x4*)dst = v;
        }
      }
    }
  }
}

DI void phase_prep(const PP p, int l) {
  bf16_t* P = (bf16_t*)(p->ws + WS_P);
  const int g0 = blockIdx.x * 256 + tidx(), G = gridDim.x * 256;
  {
    bf16_t* LIN = (bf16_t*)(p->ws + WS_LIN);
    const float* mu = p->in[12] + l * RC;
    for (int idx = g0; idx < MT * 32; idx += G) {
      const int m = idx >> 5, c8 = (idx & 31) * 8, t = tok_t(m);
      u32x4 cur = *(const u32x4*)(P + (size_t)m * MIXC + C_X + c8);
      u32x4 prv = (u32x4){0u, 0u, 0u, 0u};
      if (t > 0) prv = *(const u32x4*)(P + (size_t)(m - 1) * MIXC + C_X + c8);
      u32x4 o;
#pragma unroll
      for (int i = 0; i < 4; ++i) {
        float c0 = lo16(cur[i]), c1 = hi16(cur[i]);
        float p0, p1;
        if (t > 0) { p0 = lo16(prv[i]); p1 = hi16(prv[i]); }
        else { p0 = shift_in(p, l, m, C_X + c8 + 2 * i); p1 = shift_in(p, l, m, C_X + c8 + 2 * i + 1); }
        float v0 = c0 + (p0 - c0) * mu[C_X + c8 + 2 * i], v1 = c1 + (p1 - c1) * mu[C_X + c8 + 2 * i + 1];
        if (c8 < 64) { v0 = 2.f * sigmoidf_(2.f * v0) - 1.f; v1 = 2.f * sigmoidf_(2.f * v1) - 1.f; }
        else if (c8 >= 128) { v0 = sigmoidf_(v0); v1 = sigmoidf_(v1); }
        o[i] = pack2(v0, v1);
      }
      *(u32x4*)(LIN + (size_t)m * 256 + c8) = o;
    }
  }
  {
    const float* kg = p->in[24] + l * 64;
    for (int idx = g0; idx < MT * 2; idx += G) {
      const int m = idx >> 1, kvh = idx & 1, t = tok_t(m), b = tok_b(m);
      bf16_t* kp = P + (size_t)m * MIXC + C_SK + kvh * 64;
      float ss = 0.f;
#pragma unroll
      for (int i = 0; i < 8; ++i) {
        u32x4 v = *(const u32x4*)(kp + i * 8);
#pragma unroll
        for (int e = 0; e < 4; ++e) { float a = lo16(v[e]), c = hi16(v[e]); ss += a * a + c * c; }
      }
      const float rs = rsqrtf(ss * (1.f / 64.f) + RMS_EPS);
      float* ko = nullptr;
      if (m < TP) { if (t >= 3968) ko = p->out + O_SWK_P + (((size_t)l * 4 + b) * 128 + (t - 3968)) * 128 + kvh * 64; }
      else ko = p->out + O_SWK_S + (((size_t)l * 32 + b) * 128 + 64 + t) * 128 + kvh * 64;
#pragma unroll
      for (int i = 0; i < 8; ++i) {
        u32x4 v = *(const u32x4*)(kp + i * 8);
        u32x4 o;
#pragma unroll
        for (int e = 0; e < 4; ++e) {
          float a = lo16(v[e]) * rs * kg[i * 8 + 2 * e], c = hi16(v[e]) * rs * kg[i * 8 + 2 * e + 1];
          o[e] = pack2(a, c);
          if (ko) { ko[i * 8 + 2 * e] = a; ko[i * 8 + 2 * e + 1] = c; }
        }
        *(u32x4*)(kp + i * 8) = o;
      }
    }
  }
  {
    for (int idx = g0; idx < 4 * 128 * 128; idx += G) {
      const int c = idx & 127, j = (idx >> 7) & 127, b = idx >> 14;
      p->out[O_SWV_P + (((size_t)l * 4 + b) * 128 + j) * 128 + c] = bf2f(P[(size_t)(b * 4096 + 3968 + j) * MIXC + C_SV + c]);
    }
    for (int idx = g0; idx < 32 * 128 * 128; idx += G) {
      const int c = idx & 127, j = (idx >> 7) & 127, b = idx >> 14;
      const size_t o = (((size_t)l * 32 + b) * 128 + j) * 128 + c;
      if (j < 64) {
        const size_t s = (((size_t)l * 32 + b) * 128 + 64 + j) * 128 + c;
        p->out[O_SWK_S + o] = p->in[2][s];
        p->out[O_SWV_S + o] = p->in[3][s];
      } else {
        p->out[O_SWV_S + o] = bf2f(P[(size_t)(TP + b * 64 + (j - 64)) * MIXC + C_SV + c]);
      }
    }
  }
  {
    bf16_t* VSP = (bf16_t*)(p->ws + WS_VSP);
    for (int idx = g0; idx < 8 * 528 * 64; idx += G) {
      const int d = idx & 63, rest = idx >> 6, c8 = (rest % 528) * 8, bk = rest / 528, b = bk >> 1, kvh = bk & 1;
      u32x4 o = (u32x4){0u, 0u, 0u, 0u};
      if (c8 >= 128) {
        const bf16_t* s = P + (size_t)(b * 4096 + c8 - 128) * MIXC + C_SV + kvh * 64 + d;
#pragma unroll
        for (int i = 0; i < 4; ++i) o[i] = (unsigned)s[(size_t)(2 * i) * MIXC] | ((unsigned)s[(size_t)(2 * i + 1) * MIXC] << 16);
      }
      *(u32x4*)(VSP + ((size_t)bk * 64 + d) * VSP_LD + c8) = o;
    }
    bf16_t* VSS = (bf16_t*)(p->ws + WS_VSS);
    for (int idx = g0; idx < 64 * 24 * 64; idx += G) {
      const int d = idx & 63, rest = idx >> 6, c8 = (rest % 24) * 8, bk = rest / 24, b = bk >> 1, kvh = bk & 1;
      u32x4 o;
      if (c8 < 128) {
        const float* s = p->in[3] + (((size_t)l * 32 + b) * 128 + c8) * 128 + kvh * 64 + d;
#pragma unroll
        for (int i = 0; i < 4; ++i) o[i] = pack2(s[(2 * i) * 128], s[(2 * i + 1) * 128]);
      } else {
        const bf16_t* s = P + (size_t)(TP + b * 64 + c8 - 128) * MIXC + C_SV + kvh * 64 + d;
#pragma unroll
        for (int i = 0; i < 4; ++i) o[i] = (unsigned)s[(size_t)(2 * i) * MIXC] | ((unsigned)s[(size_t)(2 * i + 1) * MIXC] << 16);
      }
      *(u32x4*)(VSS + ((size_t)bk * 64 + d) * 192 + c8) = o;
    }
    bf16_t* VM = (bf16_t*)(p->ws + WS_VM);
    for (int idx = g0; idx < 144 * 32 * 128; idx += G) {
      const int d = idx & 127, rest = idx >> 7, m8 = (rest & 31) * 8, bh = rest >> 5, bb = bh >> 2, h = bh & 3;
      const float* s = bb < 4 ? p->out + O_MV_P + (((size_t)l * 4 + bb) * 256 + m8) * 512 + h * 128 + d
                              : p->in[5] + (((size_t)l * 32 + (bb - 4)) * 256 + m8) * 512 + h * 128 + d;
      u32x4 o;
#pragma unroll
      for (int i = 0; i < 4; ++i) o[i] = pack2(s[(2 * i) * 512], s[(2 * i + 1) * 512]);
      *(u32x4*)(VM + ((size_t)bh * 128 + d) * 256 + m8) = o;
    }
  }
  {
    const float* kg = p->in[29] + l * 128;
    for (int idx = g0; idx < 4096; idx += G) {
      float* kp = p->out + O_MK_P + (size_t)l * 1024 * 512 + (size_t)idx * 128;
      float ss = 0.f;
#pragma unroll 4
      for (int i = 0; i < 32; ++i) { f32x4 v = *(const f32x4*)(kp + i * 4); ss += v[0] * v[0] + v[1] * v[1] + v[2] * v[2] + v[3] * v[3]; }
      const float rs = rsqrtf(ss * (1.f / 128.f) + RMS_EPS);
#pragma unroll 4
      for (int i = 0; i < 32; ++i) {
        f32x4 v = *(const f32x4*)(kp + i * 4);
        f32x4 g = *(const f32x4*)(kg + i * 4);
        *(f32x4*)(kp + i * 4) = v * rs * g;
      }
    }
  }
}

DI void phase_lora(const PP p, int l, unsigned char* smem) {
  const bf16_t* LIN = (const bf16_t*)(p->ws + WS_LIN);
  for (int t = blockIdx.x; t < 144 * 4 * 2; t += gridDim.x) {
    const int which = t / 576, tt = t % 576, m0 = (tt >> 2) * 128, n0 = (tt & 3) * 128;
    f32x4 acc[4][4];
    zero_acc<4, 4>(acc);
    gemm_acc<4, 4>(acc, LIN + (size_t)m0 * 256 + which * 64, 256, (const bf16_t*)(p->ws + (which ? WS_WA2 : WS_WW2)) + (size_t)n0 * 64, 64, 64, smem);
    bf16_t* dst = (bf16_t*)(p->ws + (which ? WS_AA : WS_LD));
    const float* bias = (which ? p->in[15] : p->in[13]) + l * 512;
    EPI_IDX(4, 4)
    u32x2 ov[4][4];
#pragma unroll
    for (int i = 0; i < 4; ++i) {
      const int m = mb_ + i * 16;
#pragma unroll
      for (int j = 0; j < 4; ++j) {
        const int n = nb_ + j * 16;
        f32x4 bv = *(const f32x4*)(bias + n);
        f32x4 v = acc[i][j] + bv;
#pragma unroll
        for (int r = 0; r < 4; ++r) {
          if (which) v[r] = sigmoidf_(v[r]);
          else v[r] = -0.6065306597126334f * sigmoidf_(v[r]);
        }
        ov[i][j][0] = pack2(v[0], v[1]); ov[i][j][1] = pack2(v[2], v[3]);
      }
    }
    store_tile<4>(ov, dst, 512, m0, n0, smem);
  }
}

DI void gates_tile(const PP p, int l, int m0, int n0, unsigned char* smem) {
  const float* rs1 = (const float*)(p->ws + WS_RS1);
  const bool early = n0 < 2048;
  bf16_t* G = early ? (bf16_t*)p->out : (bf16_t*)(p->ws + WS_P);
  const size_t ldg = early ? 2048 : MIXC;
  f32x4 acc[4][4];
  zero_acc<4, 4>(acc);
  gemm_acc<4, 4>(acc, (const bf16_t*)(p->ws + WS_XB) + (size_t)m0 * 1024, 1024, (const bf16_t*)(p->ws + WS_WIN) + (size_t)(MIXC + n0) * 1024, 1024, 1024, smem);
  EPI_IDX(4, 4)
  u32x2 ov[4][4];
#pragma unroll
  for (int i = 0; i < 4; ++i) {
    const float rs = rs1[mb_ + i * 16];
#pragma unroll
    for (int j = 0; j < 4; ++j) {
      f32x4 v = acc[i][j] * rs;
      ov[i][j][0] = pack2(sigmoidf_(v[0]), sigmoidf_(v[1])); ov[i][j][1] = pack2(sigmoidf_(v[2]), sigmoidf_(v[3]));
    }
  }
  store_tile<4>(ov, G, ldg, m0, n0, smem);
}

constexpr int TC = 32;
template <int CTRL> DI float dpp_mov(float x) {
  return __int_as_float(__builtin_amdgcn_update_dpp(0, __float_as_int(x), CTRL, 0xf, 0xf, true));
}
DI float allreduce8(float x) {
  x = dpp_add<0xB1>(x);
  x = dpp_add<0x4E>(x);
  x = dpp_add<0x141>(x);
  return x;
}
DI void unpack8(u32x4 v, float (&f)[8]) {
#pragma unroll
  for (int e = 0; e < 4; ++e) { f[2 * e] = lo16(v[e]); f[2 * e + 1] = hi16(v[e]); }
}
DI void rwkv_unit(const PP p, int l, int grp, int b, int h, int rg, unsigned char* smem) {
  const bf16_t* P = (const bf16_t*)(p->ws + WS_P);
  const bf16_t* LD = (const bf16_t*)(p->ws + WS_LD);
  const bf16_t* AA = (const bf16_t*)(p->ws + WS_AA);
  bf16_t* OA = (bf16_t*)(p->ws + WS_OA);
  float* BON = (float*)(p->ws + WS_BON);
  float* sr = (float*)smem;
  float* sw = sr + TC * 64;
  float* sk = sw + TC * 64;
  float* skk = sk + TC * 64;
  float* sb = skk + TC * 64;
  float* sv = sb + TC * 64;
  const int tid = tidx();
  const int row = tid >> 4, kq = tid & 15;
  const int stt = tid >> 3, kg = tid & 7;
  const int T = grp ? 64 : 4096;
  const int mbase = grp ? TP + b * 64 : b * 4096;
  const int vrow = rg * 16 + row;
  f32x4 S = (f32x4){0.f, 0.f, 0.f, 0.f};
  if (grp) S = *(const f32x4*)(p->in[6] + ((((size_t)l * 32 + b) * 8 + h) * 64 + vrow) * 64 + kq * 4);
  const int c0 = h * 64 + kg * 8;
  u32x4 cR, cK, cV, pR, pK, pV, aA, aL;
  auto issue = [&](int t0) {
    const int m = mbase + t0 + stt;
    const bf16_t* pr = P + (size_t)m * MIXC + c0;
    cR = *(const u32x4*)(pr + C_R); cK = *(const u32x4*)(pr + C_K); cV = *(const u32x4*)(pr + C_V);
    const bf16_t* pp = (t0 + stt > 0) ? pr - MIXC : pr;
    pR = *(const u32x4*)(pp + C_R); pK = *(const u32x4*)(pp + C_K); pV = *(const u32x4*)(pp + C_V);
    aA = *(const u32x4*)(AA + (size_t)m * 512 + c0);
    aL = *(const u32x4*)(LD + (size_t)m * 512 + c0);
  };
  issue(0);
  for (int t0 = 0; t0 < T; t0 += TC) {
    {
      const int t = t0 + stt, m = mbase + t;
      float fr[8], fk[8], fv[8], qr[8], qk[8], qv[8], fa[8], fl[8];
      unpack8(cR, fr); unpack8(cK, fk); unpack8(cV, fv);
      unpack8(pR, qr); unpack8(pK, qk); unpack8(pV, qv);
      unpack8(aA, fa); unpack8(aL, fl);
      if (t == 0) {
#pragma unroll
        for (int e = 0; e < 8; ++e) { qr[e] = shift_in(p, l, m, C_R + c0 + e); qk[e] = shift_in(p, l, m, C_K + c0 + e); qv[e] = shift_in(p, l, m, C_V + c0 + e); }
      }
      const float* mu = p->in[12] + l * RC;
      const float* kkw = p->in[18] + l * 512 + c0;
      const float* kaw = p->in[19] + l * 512 + c0;
      const float* rkw = p->in[20] + l * 512 + c0;
      float nn = 0.f, bn = 0.f;
      float kkv[8], km[8];
#pragma unroll
      for (int e = 0; e < 8; ++e) {
        fr[e] = fr[e] + (qr[e] - fr[e]) * mu[C_R + c0 + e];
        fk[e] = fk[e] + (qk[e] - fk[e]) * mu[C_K + c0 + e];
        fv[e] = fv[e] + (qv[e] - fv[e]) * mu[C_V + c0 + e];
        kkv[e] = fk[e] * kkw[e];
        nn += kkv[e] * kkv[e];
        km[e] = fk[e] * (1.f + (fa[e] - 1.f) * kaw[e]);
        bn += fr[e] * km[e] * rkw[e];
      }
      nn = allreduce8(nn);
      const float inv = __builtin_amdgcn_rsqf(fmaxf(nn, 1e-24f));
      float* d;
      d = sr + stt * 64 + kg * 8;
      *(f32x4*)d = (f32x4){fr[0], fr[1], fr[2], fr[3]}; *(f32x4*)(d + 4) = (f32x4){fr[4], fr[5], fr[6], fr[7]};
      d = sw + stt * 64 + kg * 8;
      *(f32x4*)d = (f32x4){__expf(fl[0]), __expf(fl[1]), __expf(fl[2]), __expf(fl[3])};
      *(f32x4*)(d + 4) = (f32x4){__expf(fl[4]), __expf(fl[5]), __expf(fl[6]), __expf(fl[7])};
      d = sk + stt * 64 + kg * 8;
      *(f32x4*)d = (f32x4){km[0], km[1], km[2], km[3]}; *(f32x4*)(d + 4) = (f32x4){km[4], km[5], km[6], km[7]};
      d = skk + stt * 64 + kg * 8;
      *(f32x4*)d = (f32x4){kkv[0] * inv, kkv[1] * inv, kkv[2] * inv, kkv[3] * inv};
      *(f32x4*)(d + 4) = (f32x4){kkv[4] * inv, kkv[5] * inv, kkv[6] * inv, kkv[7] * inv};
      d = sb + stt * 64 + kg * 8;
      *(f32x4*)d = (f32x4){kkv[0] * inv * fa[0], kkv[1] * inv * fa[1], kkv[2] * inv * fa[2], kkv[3] * inv * fa[3]};
      *(f32x4*)(d + 4) = (f32x4){kkv[4] * inv * fa[4], kkv[5] * inv * fa[5], kkv[6] * inv * fa[6], kkv[7] * inv * fa[7]};
      if ((kg >> 1) == rg) {
        d = sv + stt * 16 + (kg & 1) * 8;
        *(f32x4*)d = (f32x4){fv[0], fv[1], fv[2], fv[3]}; *(f32x4*)(d + 4) = (f32x4){fv[4], fv[5], fv[6], fv[7]};
      }
      if (rg == 0) {
        bn = allreduce8(bn);
        if (kg == 0) BON[(size_t)m * 8 + h] = bn;
      }
    }
    __syncthreads();
    if (t0 + TC < T) issue(t0 + TC);
    float ok0 = 0.f, ok1 = 0.f;
    const float* bs = (const float*)smem + kq * 4;
    f32x4 nkk = *(const f32x4*)(bs + 3 * TC * 64), nw = *(const f32x4*)(bs + TC * 64), nb = *(const f32x4*)(bs + 4 * TC * 64),
          nk = *(const f32x4*)(bs + 2 * TC * 64), nr = *(const f32x4*)bs;
    float nv = sv[row];
#pragma unroll
    for (int tt = 0; tt < TC; ++tt) {
      const f32x4 kk4 = nkk, w4 = nw, b4 = nb, k4 = nk, r4 = nr;
      const float v = nv;
      if (tt + 1 < TC) {
        const float* bn_ = bs + (tt + 1) * 64;
        nkk = *(const f32x4*)(bn_ + 3 * TC * 64); nw = *(const f32x4*)(bn_ + TC * 64); nb = *(const f32x4*)(bn_ + 4 * TC * 64);
        nk = *(const f32x4*)(bn_ + 2 * TC * 64); nr = *(const f32x4*)bn_;
        nv = sv[(tt + 1) * 16 + row];
      }
      float d = S[0] * kk4[0] + S[1] * kk4[1] + S[2] * kk4[2] + S[3] * kk4[3];
      d = allreduce16(d);
      const float sa = -d;
      S = S * w4 + sa * b4 + v * k4;
      float o = S[0] * r4[0] + S[1] * r4[1] + S[2] * r4[2] + S[3] * r4[3];
      o = allreduce16(o);
      if (tt < 16) ok0 = (kq == tt) ? o : ok0;
      else ok1 = (kq == tt - 16) ? o : ok1;
    }
    {
      bf16_t* so = (bf16_t*)(sv + TC * 16);
      so[kq * 16 + row] = f2bf(ok0);
      so[(16 + kq) * 16 + row] = f2bf(ok1);
      __syncthreads();
      if (tid < 64) {
        const int tk = tid >> 1, hf = tid & 1;
        *(u32x4*)(OA + (size_t)(mbase + t0 + tk) * 512 + h * 64 + rg * 16 + hf * 8) = *(const u32x4*)(so + tk * 16 + hf * 8);
      }
    }
  }
  float* sout = grp ? p->out + O_RW_S + ((((size_t)l * 32 + b) * 8 + h) * 64 + vrow) * 64 + kq * 4
                    : p->out + O_RW_P + ((((size_t)l * 4 + b) * 8 + h) * 64 + vrow) * 64 + kq * 4;
  *(f32x4*)sout = S;
}

template <int HD, int NKT, int MODE>
DI void attn16(const PP p, int l, const bf16_t* qrow, const float* qg, float qscale, const float* kf32, const bf16_t* kbf,
               const bf16_t* vt, int ldv, bf16_t* orow, int qi0, int chunk, float slope, float sink) {
  const int lane = tidx() & 63, l15 = lane & 15, quad = lane >> 4;
  constexpr int NKS = HD / 32;
  bf16x8 qf[NKS];
  {
    float qv[NKS][8];
    float ss = 0.f;
#pragma unroll
    for (int ks = 0; ks < NKS; ++ks) {
      u32x4 v = *(const u32x4*)(qrow + ks * 32 + quad * 8);
#pragma unroll
      for (int e = 0; e < 4; ++e) { qv[ks][2 * e] = lo16(v[e]); qv[ks][2 * e + 1] = hi16(v[e]); ss += qv[ks][2 * e] * qv[ks][2 * e] + qv[ks][2 * e + 1] * qv[ks][2 * e + 1]; }
    }
    ss += __shfl_xor(ss, 16);
    ss += __shfl_xor(ss, 32);
    const float rs = rsqrtf(ss * (1.f / HD) + RMS_EPS) * qscale;
#pragma unroll
    for (int ks = 0; ks < NKS; ++ks) {
      const float* g = qg + ks * 32 + quad * 8;
      u32x4 o;
#pragma unroll
      for (int e = 0; e < 4; ++e) o[e] = pack2(qv[ks][2 * e] * rs * g[2 * e], qv[ks][2 * e + 1] * rs * g[2 * e + 1]);
      qf[ks] = __builtin_bit_cast(bf16x8, o);
    }
  }
  f32x4 s[NKT];
  float mx = -INFINITY;
#pragma unroll
  for (int kt = 0; kt < NKT; ++kt) {
    f32x4 acc = (f32x4){0.f, 0.f, 0.f, 0.f};
    const int key = kt * 16 + l15;
#pragma unroll
    for (int ks = 0; ks < NKS; ++ks) {
      bf16x8 kfr;
      const int d0 = ks * 32 + quad * 8;
      if constexpr (MODE == 0 || MODE == 4) {
        const float* kp = kf32 + (size_t)key * 512 + d0;
        kfr = cvt8(*(const f32x4*)kp, *(const f32x4*)(kp + 4));
      } else if constexpr (MODE == 1) {
        int tokrel = (chunk - 2) * 64 + key;
        if (tokrel < 0) tokrel = 0;
        kfr = *(const bf16x8*)(kbf + (size_t)tokrel * MIXC + d0);
      } else if constexpr (MODE == 3) {
        kfr = *(const bf16x8*)((const unsigned char*)kbf + key * 128 + (((ks * 4 + quad) ^ (key & 7)) * 16));
      } else {
        if (kt < 8) {
          const float* kp = kf32 + (size_t)key * 128 + d0;
          kfr = cvt8(*(const f32x4*)kp, *(const f32x4*)(kp + 4));
        } else {
          kfr = *(const bf16x8*)(kbf + (size_t)(key - 128) * MIXC + d0);
        }
      }
      acc = MFMA16(kfr, qf[ks], acc);
    }
    if constexpr (MODE != 0 && MODE != 4) {
#pragma unroll
      for (int r = 0; r < 4; ++r) {
        const int kj = kt * 16 + quad * 4 + r;
        const float dist = fabsf((float)(128 + qi0 + l15 - kj));
        acc[r] = acc[r] - slope * dist;
        if ((MODE == 1 || MODE == 3) && (chunk - 2 + (kj >> 6)) < 0) acc[r] = -INFINITY;
      }
    }
    s[kt] = acc;
    mx = fmaxf(mx, fmaxf(fmaxf(acc[0], acc[1]), fmaxf(acc[2], acc[3])));
    if (MODE != 4 || (kt & 1)) __builtin_amdgcn_sched_barrier(0);
  }
  mx = fmaxf(mx, __shfl_xor(mx, 16));
  mx = fmaxf(mx, __shfl_xor(mx, 32));
  if constexpr (MODE != 0 && MODE != 4) mx = fmaxf(mx, sink);
  float sum = 0.f;
#pragma unroll
  for (int kt = 0; kt < NKT; ++kt)
#pragma unroll
    for (int r = 0; r < 4; ++r) { const float e = __expf(s[kt][r] - mx); s[kt][r] = e; sum += e; }
  sum += __shfl_xor(sum, 16);
  sum += __shfl_xor(sum, 32);
  if constexpr (MODE != 0 && MODE != 4) sum += __expf(sink - mx);
  const float inv = 1.f / sum;
  f32x4 o[HD / 16];
#pragma unroll
  for (int dt = 0; dt < HD / 16; ++dt) o[dt] = (f32x4){0.f, 0.f, 0.f, 0.f};
#pragma unroll
  for (int kb = 0; kb < NKT / 2; ++kb) {
    u32x4 pp;
    pp[0] = pack2(s[2 * kb][0], s[2 * kb][1]); pp[1] = pack2(s[2 * kb][2], s[2 * kb][3]);
    pp[2] = pack2(s[2 * kb + 1][0], s[2 * kb + 1][1]); pp[3] = pack2(s[2 * kb + 1][2], s[2 * kb + 1][3]);
    const bf16x8 pf = __builtin_bit_cast(bf16x8, pp);
#pragma unroll
    for (int dt = 0; dt < HD / 16; ++dt) {
      u32x2 v0, v1;
      if constexpr (MODE == 4) {
        const unsigned char* vr = (const unsigned char*)vt + (dt * 16 + l15) * 512 + (quad & 1) * 8;
        const int c0 = kb * 4 + (quad >> 1);
        v0 = *(const u32x2*)(vr + ((c0 ^ l15) * 16));
        v1 = *(const u32x2*)(vr + (((c0 + 2) ^ l15) * 16));
      } else {
        const bf16_t* vp = vt + (size_t)(dt * 16 + l15) * ldv + kb * 32 + quad * 4;
        v0 = *(const u32x2*)vp; v1 = *(const u32x2*)(vp + 16);
      }
      u32x4 vv; vv[0] = v0[0]; vv[1] = v0[1]; vv[2] = v1[0]; vv[3] = v1[1];
      o[dt] = MFMA16(__builtin_bit_cast(bf16x8, vv), pf, o[dt]);
    }
    __builtin_amdgcn_sched_barrier(0);
  }
#pragma unroll
  for (int dt = 0; dt < HD / 16; ++dt) {
    u32x2 ov; ov[0] = pack2(o[dt][0] * inv, o[dt][1] * inv); ov[1] = pack2(o[dt][2] * inv, o[dt][3] * inv);
    *(u32x2*)(orow + dt * 16 + quad * 4) = ov;
  }
}

constexpr int Q_REC_S = 1024, Q_SWA = 576, Q_MEM = 1152, Q_TOTAL = Q_REC_S + Q_SWA + Q_MEM;
DI void phase_mixers(const PP p, int l, unsigned char* smem, int slot) {
  const int tid = tidx(), w = tid >> 6, lane = tid & 63, l15 = lane & 15;
  const bf16_t* P = (const bf16_t*)(p->ws + WS_P);
  unsigned* ctr = (unsigned*)(p->ws + WS_CTR) + slot * 16;
  int* sitem = (int*)(smem + 65536 + 16);
  if (blockIdx.x < 128) rwkv_unit(p, l, 0, blockIdx.x >> 5, (blockIdx.x >> 2) & 7, blockIdx.x & 3, smem);
  const bool quiet_ = (gridDim.x == 512) && (blockIdx.x >= 256) && (blockIdx.x < 384);
  for (; !quiet_;) {
    __syncthreads();
    if (tid == 0) *sitem = (int)atomicAdd(ctr, 1u);
    __syncthreads();
    int item = *sitem;
    if (item >= Q_TOTAL) break;
    item = __builtin_amdgcn_readfirstlane(item);
    asm volatile("" : "+s"(item));
    if (item < Q_REC_S) {
      rwkv_unit(p, l, 1, item >> 5, (item >> 2) & 7, item & 3, smem);
    } else if (item < Q_REC_S + Q_SWA) {
      const int u = item - Q_REC_S;
      const float* qg = p->in[23] + l * 64;
      if (u < 512) {
        const int kvh = u & 1, chunk = (u >> 1) & 63, b = u >> 7, h = kvh * 4 + w;
        const float slope = exp2f(-(float)(h + 1)), sink = p->in[25][l * 8 + h];
        const bf16_t* kb = P + (size_t)(b * 4096) * MIXC + C_SK + kvh * 64;
        const bf16_t* vt = (const bf16_t*)(p->ws + WS_VSP) + (size_t)(b * 2 + kvh) * 64 * VSP_LD + chunk * 64;
        unsigned char* Kl = smem;
        bf16_t* Vl = (bf16_t*)(smem + 24576);
#pragma unroll 2
        for (int k = 0; k < 6; ++k) {
          const int idx = tid + k * 256, r = idx >> 3, c = idx & 7;
          int tokrel = (chunk - 2) * 64 + r;
          if (tokrel < 0) tokrel = 0;
          *(u32x4*)(Kl + r * 128 + ((c ^ (r & 7)) * 16)) = *(const u32x4*)(kb + (size_t)tokrel * MIXC + c * 8);
          const int d = idx / 24, ch = idx % 24;
          *(u32x4*)(Vl + d * 200 + ch * 8) = *(const u32x4*)(vt + (size_t)d * VSP_LD + ch * 8);
        }
        __syncthreads();
#pragma unroll 1
        for (int qs = 0; qs < 4; ++qs) {
          const int m = b * 4096 + chunk * 64 + qs * 16 + l15;
          attn16<64, 12, 3>(p, l, P + (size_t)m * MIXC + C_Q + h * 64, qg, 0.125f, nullptr, (const bf16_t*)Kl, Vl, 200,
                            (bf16_t*)(p->ws + WS_OB) + (size_t)m * 512 + h * 64, qs * 16, chunk, slope, sink);
        }
      } else {
        const int v = u - 512, kvh = v & 1, b = v >> 1, h = kvh * 4 + w;
        const float slope = exp2f(-(float)(h + 1)), sink = p->in[25][l * 8 + h];
        const float* kc = p->in[2] + ((size_t)l * 32 + b) * 128 * 128 + kvh * 64;
        const bf16_t* kb = P + (size_t)(TP + b * 64) * MIXC + C_SK + kvh * 64;
        const bf16_t* vt = (const bf16_t*)(p->ws + WS_VSS) + (size_t)(b * 2 + kvh) * 64 * 192;
        unsigned char* Kl = smem;
        bf16_t* Vl = (bf16_t*)(smem + 24576);
#pragma unroll 2
        for (int k = 0; k < 6; ++k) {
          const int idx = tid + k * 256, r = idx >> 3, c = idx & 7;
          u32x4 kv;
          if (r < 128) { const float* kp = kc + (size_t)r * 128 + c * 8; kv = __builtin_bit_cast(u32x4, cvt8(*(const f32x4*)kp, *(const f32x4*)(kp + 4))); }
          else kv = *(const u32x4*)(kb + (size_t)(r - 128) * MIXC + c * 8);
          *(u32x4*)(Kl + r * 128 + ((c ^ (r & 7)) * 16)) = kv;
          const int d = idx / 24, ch = idx % 24;
          *(u32x4*)(Vl + d * 200 + ch * 8) = *(const u32x4*)(vt + (size_t)d * 192 + ch * 8);
        }
        __syncthreads();
#pragma unroll 1
        for (int qs = 0; qs < 4; ++qs) {
          const int m = TP + b * 64 + qs * 16 + l15;
          attn16<64, 12, 3>(p, l, P + (size_t)m * MIXC + C_Q + h * 64, qg, 0.125f, nullptr, (const bf16_t*)Kl, Vl, 200,
                            (bf16_t*)(p->ws + WS_OB) + (size_t)m * 512 + h * 64, qs * 16, 2, slope, sink);
        }
      }
    } else {
      const int u = item - Q_REC_S - Q_SWA, h = u & 3, tile = u >> 2;
      const int m = tile * 64 + w * 16 + l15;
      const int bb = m < TP ? (m >> 12) : 4 + ((m - TP) >> 6);
      const float* kf = (bb < 4 ? p->out + O_MK_P + ((size_t)l * 4 + bb) * 256 * 512 : p->in[4] + ((size_t)l * 32 + (bb - 4)) * 256 * 512) + h * 128;
      const bf16_t* vt = (const bf16_t*)(p->ws + WS_VM) + (size_t)(bb * 4 + h) * 128 * 256;
#pragma unroll 4
      for (int k = 0; k < 16; ++k) {
        const int idx = tid + k * 256, d = idx >> 5, ch = idx & 31;
        *(u32x4*)(smem + d * 512 + ((ch ^ (d & 15)) * 16)) = *(const u32x4*)(vt + (size_t)d * 256 + ch * 8);
      }
      __syncthreads();
      attn16<128, 16, 4>(p, l, P + (size_t)m * MIXC + C_QM + h * 128, p->in[28] + l * 128, 0.08838834764831845f, kf, nullptr, (const bf16_t*)smem, 256,
                         (bf16_t*)(p->ws + WS_OM) + (size_t)m * 512 + h * 128, 0, 0, 0.f, 0.f);
    }
  }
  if ((blockIdx.x & 255) >= 128) {
    for (;;) {
      __syncthreads();
      if (tid == 0) *sitem = (int)atomicAdd(ctr + 8, 1u);
      __syncthreads();
      int u = *sitem;
      if (u >= 2304) break;
      u = __builtin_amdgcn_readfirstlane(u);
      gates_tile(p, l, (u >> 4) * 128, (u & 15) * 128, smem);
    }
  }
}

DI void phase_post(const PP p, int l, unsigned char* smem) {
  const bf16_t* P = (const bf16_t*)(p->ws + WS_P);
  const bf16_t* LIN = (const bf16_t*)(p->ws + WS_LIN);
  bf16_t* OA = (bf16_t*)(p->ws + WS_OA);
  const float* BON = (const float*)(p->ws + WS_BON);
  const float* lng = p->in[21] + l * 512;
  const float* lnb = p->in[22] + l * 512;
  const float* muv = p->in[12] + l * RC + C_V;
  for (int t = blockIdx.x; t < 144 * 4; t += gridDim.x) {
    const int m0 = (t >> 2) * 128, n0 = (t & 3) * 128;
    f32x4 acc[4][4];
    zero_acc<4, 4>(acc);
    gemm_acc<4, 4>(acc, LIN + (size_t)m0 * 256 + 128, 256, (const bf16_t*)(p->ws + WS_WG2) + (size_t)n0 * 128, 128, 128, smem);
    EPI_IDX(4, 4)
    __syncthreads();
    const int hh = (n0 + wn_ * 64) >> 6;
#pragma unroll
    for (int i = 0; i < 4; ++i) {
      const int m = mb_ + i * 16, tt = tok_t(m);
      float ov[4][4];
      float sm = 0.f;
#pragma unroll
      for (int j = 0; j < 4; ++j) {
        u32x2 v = *(const u32x2*)(OA + (size_t)m * 512 + nb_ + j * 16);
        ov[j][0] = lo16(v[0]); ov[j][1] = hi16(v[0]); ov[j][2] = lo16(v[1]); ov[j][3] = hi16(v[1]);
        sm += ov[j][0] + ov[j][1] + ov[j][2] + ov[j][3];
      }
      sm += __shfl_xor(sm, 16);
      sm += __shfl_xor(sm, 32);
      const float mean = sm * (1.f / 64.f);
      float vs = 0.f;
#pragma unroll
      for (int j = 0; j < 4; ++j)
#pragma unroll
        for (int r = 0; r < 4; ++r) { const float d = ov[j][r] - mean; vs += d * d; }
      vs += __shfl_xor(vs, 16);
      vs += __shfl_xor(vs, 32);
      const float rstd = rsqrtf(vs * (1.f / 64.f) + GN_EPS);
      const float bon = BON[(size_t)m * 8 + hh];
#pragma unroll
      for (int j = 0; j < 4; ++j) {
        const int n = nb_ + j * 16;
        u32x2 cv = *(const u32x2*)(P + (size_t)m * MIXC + C_V + n);
        float pv[4] = {lo16(cv[0]), hi16(cv[0]), lo16(cv[1]), hi16(cv[1])};
        float qv[4];
        if (tt > 0) {
          u32x2 pvv = *(const u32x2*)(P + (size_t)(m - 1) * MIXC + C_V + n);
          qv[0] = lo16(pvv[0]); qv[1] = hi16(pvv[0]); qv[2] = lo16(pvv[1]); qv[3] = hi16(pvv[1]);
        } else {
#pragma unroll
          for (int r = 0; r < 4; ++r) qv[r] = shift_in(p, l, m, C_V + n + r);
        }
        float res[4];
#pragma unroll
        for (int r = 0; r < 4; ++r) {
          const float vmix = pv[r] + (qv[r] - pv[r]) * muv[n + r];
          res[r] = ((ov[j][r] - mean) * rstd * lng[n + r] + lnb[n + r] + bon * vmix) * acc[i][j][r];
        }
        { u32x2 o_; o_[0] = pack2(res[0], res[1]); o_[1] = pack2(res[2], res[3]);
          *(u32x2*)(smem + (wm_ * 64 + i * 16 + l15_) * 272 + (wn_ * 64 + j * 16 + quad_ * 4) * 2) = o_; }
      }
    }
    tile_flush<4>(OA, 512, m0, n0, smem);
  }
}

DI void phase_gates(const PP p, int l, unsigned char* smem) {
  const int nt = 8, nb = 16;
  for (int t = blockIdx.x; t < 144 * nt; t += gridDim.x) gates_tile(p, l, (t / nt) * 128, (nb + t % nt) * 128, smem);
}
DI void phase_merge(const PP p, int l, unsigned char* smem) {
  const bf16_t* G = (const bf16_t*)(p->ws + WS_P);
  bf16_t* MG = (bf16_t*)(p->ws + WS_LD);
  for (int t = blockIdx.x; t < 144 * 16; t += gridDim.x) {
    const int m0 = (t >> 4) * 128, n0 = (t & 15) * 64;
    f32x4 mg[4][2];
    zero_acc<4, 2>(mg);
    EPI_IDX(4, 2)
#pragma unroll 1
    for (int br = 0; br < 3; ++br) {
      f32x4 ab[4][2];
      zero_acc<4, 2>(ab);
      gemm_acc<4, 2>(ab, (const bf16_t*)(p->ws + WS_OA + (size_t)br * 18874368) + (size_t)m0 * 512, 512,
                     (const bf16_t*)(p->ws + WS_WBR + (size_t)br * 1048576) + (size_t)n0 * 512, 512, 512, smem);
#pragma unroll
      for (int i = 0; i < 4; ++i)
#pragma unroll
        for (int j = 0; j < 2; ++j) {
          const bf16_t* gp = (br < 2) ? (const bf16_t*)p->out + (size_t)(mb_ + i * 16) * 2048 + br * 1024 + nb_ + j * 16
                                                : G + (size_t)(mb_ + i * 16) * MIXC + br * 1024 + nb_ + j * 16;
          const u32x2 g = *(const u32x2*)gp;
          mg[i][j][0] += lo16(g[0]) * ab[i][j][0];
          mg[i][j][1] += hi16(g[0]) * ab[i][j][1];
          mg[i][j][2] += lo16(g[1]) * ab[i][j][2];
          mg[i][j][3] += hi16(g[1]) * ab[i][j][3];
        }
      __builtin_amdgcn_sched_barrier(0);
    }
    u32x2 ov[4][2];
#pragma unroll
    for (int i = 0; i < 4; ++i)
#pragma unroll
      for (int j = 0; j < 2; ++j) {
        ov[i][j][0] = pack2(mg[i][j][0], mg[i][j][1]); ov[i][j][1] = pack2(mg[i][j][2], mg[i][j][3]);
      }
    store_tile<2>(ov, MG, 1024, m0, n0, smem);
  }
}

DI f32x4 resid4(const PP p, int l, int m, int n) {
  if (l == 0) return *(const f32x4*)(xrow(p, 0, m) + n);
  const u32x2 v = *(const u32x2*)((const bf16_t*)(p->ws + WS_XB) + (size_t)m * 1024 + n);
  return (f32x4){lo16(v[0]), hi16(v[0]), lo16(v[1]), hi16(v[1])};
}
DI void phase_out(const PP p, int l, unsigned char* smem) {
  const bf16_t* MG = (const bf16_t*)(p->ws + WS_LD);
  for (int t = blockIdx.x; t < 1024; t += gridDim.x) {
    const int m0 = (t >> 3) * 128, n0 = (t & 7) * 128;
    f32x4 acc[4][4];
    zero_acc<4, 4>(acc);
    gemm_acc<4, 4>(acc, MG + (size_t)m0 * 1024, 1024, (const bf16_t*)(p->ws + WS_WOUT) + (size_t)n0 * 1024, 1024, 1024, smem);
    EPI_IDX(4, 4)
#pragma unroll
    for (int i = 0; i < 4; ++i) {
      const int m = mb_ + i * 16;
#pragma unroll
      for (int j = 0; j < 4; ++j) {
        const int n = nb_ + j * 16;
        f32x4 xv = resid4(p, l, m, n);
        *(f32x4*)(p->out + (size_t)m * DM + n) = xv + acc[i][j];
      }
    }
  }
  for (int hb = blockIdx.x; hb < 256; hb += gridDim.x) {
    const int t = 1024 + (hb >> 1), m0 = (t >> 3) * 128, n0 = (t & 7) * 128 + (hb & 1) * 64;
    f32x4 acc[4][2];
    zero_acc<4, 2>(acc);
    gemm_acc<4, 2>(acc, MG + (size_t)m0 * 1024, 1024, (const bf16_t*)(p->ws + WS_WOUT) + (size_t)n0 * 1024, 1024, 1024, smem);
    EPI_IDX(4, 2)
#pragma unroll
    for (int i = 0; i < 4; ++i) {
      const int m = mb_ + i * 16;
#pragma unroll
      for (int j = 0; j < 2; ++j) {
        const int n = nb_ + j * 16;
        f32x4 xv = resid4(p, l, m, n);
        *(f32x4*)(p->out + (size_t)m * DM + n) = xv + acc[i][j];
      }
    }
  }
}

DI void phase_up_a(const PP p, int l, unsigned char* smem) {
  const float* rs2 = (const float*)(p->ws + WS_RS2);
  bf16_t* AIN = (bf16_t*)(p->ws + WS_P);
  for (int t = blockIdx.x; t < 144 * 22; t += gridDim.x) {
    const int m0 = (t / 22) * 128, n0 = (t % 22) * 128;
    f32x4 acc[4][4];
    zero_acc<4, 4>(acc);
    gemm_acc<4, 4>(acc, (const bf16_t*)(p->ws + WS_XB) + (size_t)m0 * 1024, 1024, (const bf16_t*)(p->ws + WS_WUP) + (size_t)n0 * 1024, 1024, 1024, smem);
    EPI_IDX(4, 4)
    u32x2 ov[4][4];
#pragma unroll
    for (int i = 0; i < 4; ++i) {
      const int m = mb_ + i * 16, tt = tok_t(m), T = m < TP ? 4096 : 64;
      const float rs = rs2[m];
#pragma unroll
      for (int j = 0; j < 4; ++j) {
        const int n = nb_ + j * 16;
        f32x4 v = acc[i][j] * rs;
        u32x2 o; o[0] = pack2(v[0], v[1]); o[1] = pack2(v[2], v[3]);
        ov[i][j] = o;
        if (tt >= T - 2) {
          float* co = m < TP ? p->out + O_CV_P + (((size_t)l * 4 + (m >> 12)) * 2 + (tt - (T - 2))) * DFF + n
                             : p->out + O_CV_S + (((size_t)l * 32 + ((m - TP) >> 6)) * 2 + (tt - (T - 2))) * DFF + n;
          *(f32x4*)co = v;
        }
      }
    }
    store_tile<4>(ov, AIN, DFF, m0, n0, smem);
  }
}
DI float gelu_tanh(float x) {
  const float u2 = 1.5957691216057308f * (x + 0.044715f * x * x * x);
  return x * __builtin_amdgcn_rcpf(1.f + __expf(-u2));
}
DI void phase_up_u(const PP p, int l, unsigned char* smem) {
  const float* rs2 = (const float*)(p->ws + WS_RS2);
  const bf16_t* AIN = (const bf16_t*)(p->ws + WS_P);
  bf16_t* ACT = (bf16_t*)(p->ws + WS_R);
  const float* cw = p->in[34] + (size_t)l * 3 * DFF;
  const float* cb = p->in[35] + (size_t)l * DFF;
  for (int t = blockIdx.x; t < 144 * 22; t += gridDim.x) {
    const int m0 = (t / 22) * 128, n0 = (t % 22) * 128;
    f32x4 acc[4][4];
    zero_acc<4, 4>(acc);
    gemm_acc<4, 4>(acc, (const bf16_t*)(p->ws + WS_XB) + (size_t)m0 * 1024, 1024, (const bf16_t*)(p->ws + WS_WUP) + (size_t)(DFF + n0) * 1024, 1024, 1024, smem);
    EPI_IDX(4, 4)
    __syncthreads();
#pragma unroll 3
    for (int k = 0; k < 9; ++k) {
      const int idx = tid_ + k * 256, rr = idx >> 4, ch = idx & 15, mr = m0 - 2 + rr;
      if (rr < 130 && mr >= 0) *(u32x4*)(smem + rr * 272 + ch * 16) = *(const u32x4*)(AIN + (size_t)mr * DFF + n0 + ch * 8);
    }
    __syncthreads();
    u32x2 ov[4][4];
#pragma unroll
    for (int i = 0; i < 4; ++i) {
      const int m = mb_ + i * 16, tt = tok_t(m);
      const float rs = rs2[m];
#pragma unroll
      for (int j = 0; j < 4; ++j) {
        const int n = nb_ + j * 16;
        f32x4 c = *(const f32x4*)(cb + n);
#pragma unroll
        for (int jj = 0; jj < 3; ++jj) {
          const int ts = tt - 2 + jj;
          f32x4 av;
          if (ts >= 0) {
            u32x2 v = *(const u32x2*)(smem + (m - m0 + jj) * 272 + (n - n0) * 2);
            av = (f32x4){lo16(v[0]), hi16(v[0]), lo16(v[1]), hi16(v[1])};
          } else if (m >= TP) {
            av = *(const f32x4*)(p->in[8] + (((size_t)l * 32 + ((m - TP) >> 6)) * 2 + (ts + 2)) * DFF + n);
          } else {
            av = (f32x4){0.f, 0.f, 0.f, 0.f};
          }
          c += av * *(const f32x4*)(cw + jj * DFF + n);
        }
        f32x4 u = acc[i][j] * rs;
        u32x2 o; o[0] = pack2(gelu_tanh(c[0]) * u[0], gelu_tanh(c[1]) * u[1]); o[1] = pack2(gelu_tanh(c[2]) * u[2], gelu_tanh(c[3]) * u[3]);
        ov[i][j] = o;
      }
    }
    store_tile<4>(ov, ACT, DFF, m0, n0, smem);
  }
}
DI void phase_down(const PP p, int l, unsigned char* smem) {
  const bf16_t* ACT = (const bf16_t*)(p->ws + WS_R);
  for (int t = blockIdx.x; t < 1024; t += gridDim.x) {
    const int m0 = (t >> 3) * 128, n0 = (t & 7) * 128;
    f32x4 acc[4][4];
    zero_acc<4, 4>(acc);
    gemm_acc<4, 4>(acc, ACT + (size_t)m0 * DFF, DFF, (const bf16_t*)(p->ws + WS_WDN) + (size_t)n0 * DFF, DFF, DFF, smem);
    EPI_IDX(4, 4)
#pragma unroll
    for (int i = 0; i < 4; ++i) {
      const int m = mb_ + i * 16;
#pragma unroll
      for (int j = 0; j < 4; ++j) {
        float* y = p->out + (size_t)m * DM + nb_ + j * 16;
        *(f32x4*)y = *(const f32x4*)y + acc[i][j];
      }
    }
  }
  for (int hb = blockIdx.x; hb < 256; hb += gridDim.x) {
    const int t = 1024 + (hb >> 1), m0 = (t >> 3) * 128, n0 = (t & 7) * 128 + (hb & 1) * 64;
    f32x4 acc[4][2];
    zero_acc<4, 2>(acc);
    gemm_acc<4, 2>(acc, ACT + (size_t)m0 * DFF, DFF, (const bf16_t*)(p->ws + WS_WDN) + (size_t)n0 * DFF, DFF, DFF, smem);
    EPI_IDX(4, 2)
#pragma unroll
    for (int i = 0; i < 4; ++i) {
      const int m = mb_ + i * 16;
#pragma unroll
      for (int j = 0; j < 2; ++j) {
        float* y = p->out + (size_t)m * DM + nb_ + j * 16;
        *(f32x4*)y = *(const f32x4*)y + acc[i][j];
      }
    }
  }
}


#define XB_TMO      128
#define XB_XCNT(j)  (256  + 64 * (j))
#define XB_XSUB(j)  (1280 + 64 * (j))
#define XB_XGEN(j)  (2304 + 64 * (j))
#define XB_TOP      3328
#define XB_TOPGEN   3392
#define XCD_BAR_WORDS 3456
#define XB_SPIN_CAP (1u << 18)
#define LAS __attribute__((address_space(3)))
DI unsigned xb_ld(unsigned* p) { return __hip_atomic_load(p, __ATOMIC_RELAXED, __HIP_MEMORY_SCOPE_AGENT); }
DI unsigned xb_add(unsigned* p, unsigned v) { return __hip_atomic_fetch_add(p, v, __ATOMIC_RELAXED, __HIP_MEMORY_SCOPE_AGENT); }
DI unsigned xb_xcc_id() { return (unsigned)__builtin_amdgcn_s_getreg((3 << 11) | 20) & 0xFu; }
#define XB_SPIN(cond, bar) do { unsigned _sp = 0; while (cond) { __builtin_amdgcn_s_sleep(1); \
    if ((++_sp & 255u) == 0u) { if (xb_ld(&(bar)[XB_TMO])) break; if (_sp > XB_SPIN_CAP) { atomicAdd(&(bar)[XB_TMO], 1u); break; } } } } while (0)
struct XcdBarrier { unsigned* bar; unsigned x; volatile LAS unsigned* st; };
DI XcdBarrier xcd_barrier_post(unsigned* bar, volatile LAS unsigned* st) {
  XcdBarrier b; b.bar = bar; b.x = xb_xcc_id(); b.st = st;
  if (threadIdx.x == 0) (void)xb_add(&bar[XB_XCNT(b.x)], 1u);
  return b;
}
DI void xcd_barrier_complete(unsigned* bar, unsigned x, unsigned& nloc, unsigned& nx) {
  const unsigned G = gridDim.x * gridDim.y * gridDim.z;
  unsigned sum, cnt, mine, sp = 0u;
  for (;;) {
    sum = 0u; cnt = 0u; mine = 0u;
#pragma unroll
    for (unsigned j = 0; j < 16; ++j) { const unsigned c = xb_ld(&bar[XB_XCNT(j)]); sum += c; cnt += (c > 0u) ? 1u : 0u; mine = (j == x) ? c : mine; }
    if (sum == G) break;
    __builtin_amdgcn_s_sleep(1);
    if ((++sp & 255u) == 0u) { if (xb_ld(&bar[XB_TMO])) break; if (sp > XB_SPIN_CAP) { atomicAdd(&bar[XB_TMO], 1u); break; } }
  }
  nloc = mine > 0u ? mine : 1u; nx = cnt > 0u ? cnt : 1u;
}
DI void xcd_barrier(const XcdBarrier& b) {
  asm volatile("s_waitcnt vmcnt(0)" ::: "memory");
  __syncthreads();
  if (threadIdx.x == 0) {
    unsigned* bar = b.bar;
    __builtin_amdgcn_s_waitcnt(0);
    unsigned nloc = b.st[0], nx = b.st[1];
    if (nloc == 0u) { xcd_barrier_complete(bar, b.x, nloc, nx); b.st[0] = nloc; b.st[1] = nx; }
    const unsigned old = xb_add(&bar[XB_XSUB(b.x)], 1u);
    const unsigned gen = old / nloc;
    if (old + 1u == (gen + 1u) * nloc) {
      __builtin_amdgcn_fence(__ATOMIC_RELEASE, "agent");
      asm volatile("s_waitcnt vmcnt(0)" ::: "memory");
      const unsigned og = xb_add(&bar[XB_TOP], 1u);
      const unsigned tg = og / nx;
      if (og + 1u == (tg + 1u) * nx) xb_add(&bar[XB_TOPGEN], 1u);
      else XB_SPIN(xb_ld(&bar[XB_TOPGEN]) == tg, bar);
      __builtin_amdgcn_fence(__ATOMIC_ACQUIRE, "agent");
      xb_add(&bar[XB_XGEN(b.x)], 1u);
      asm volatile("s_waitcnt vmcnt(0)" ::: "memory");
    } else {
      XB_SPIN(xb_ld(&bar[XB_XGEN(b.x)]) == gen, bar);
      __builtin_amdgcn_fence(__ATOMIC_ACQUIRE, "agent");
      asm volatile("s_waitcnt vmcnt(0)" ::: "memory");
    }
  }
  __syncthreads();
}

__global__ void __launch_bounds__(256, 2) mega(Params p_arg) {
  __shared__ __attribute__((aligned(16))) unsigned char smem[65536 + 64];
  cg::grid_group grid = cg::this_grid();
  __shared__ uint4 xb_words;
  if (threadIdx.x == 0) xb_words = make_uint4(0u, 0u, 0u, 0u);
  __syncthreads();
  const XcdBarrier xb = xcd_barrier_post((unsigned*)(p_arg.ws + WS_BAR), (volatile LAS unsigned*)&xb_words);
  if (p_arg.out == nullptr) grid.sync();
#pragma unroll 1
  for (int ph = 0; ph < 26; ++ph) {
    int l = ph >= 13 ? 1 : 0;
    const __attribute__((address_space(4))) Params* kp = (const __attribute__((address_space(4))) Params*)__builtin_amdgcn_kernarg_segment_ptr();
    l = __builtin_amdgcn_readfirstlane(l);
    asm volatile("" : "+s"(kp));
    asm volatile("" : "+s"(l));
    const PP p = kp;
    switch (ph - l * 13) {
      case 0: phase_convert(p, l, smem); break;
      case 1: phase_gemm_in(p, l, smem); break;
      case 2: phase_prep(p, l); break;
      case 3: phase_lora(p, l, smem); break;
      case 4: phase_mixers(p, l, smem, ph); break;
      case 5: phase_post(p, l, smem); break;
      case 6: phase_gates(p, l, smem); break;
      case 7: phase_merge(p, l, smem); break;
      case 8: phase_out(p, l, smem); break;
      case 9: phase_stats2(p); break;
      case 10: phase_up_a(p, l, smem); break;
      case 11: phase_up_u(p, l, smem); break;
      default: phase_down(p, l, smem); break;
    }
    if (ph + 1 < 26) xcd_barrier(xb);
  }
}

extern "C" void kernel_launch(void* const* d_in, const int* in_sizes, int n_in, void* d_out, int out_size, void* d_ws, size_t ws_size,
                              hipStream_t stream) {
  static int grid_blocks = 0;
  if (!grid_blocks) {
    int dev = 0, cus = 0, per_cu = 0;
    (void)hipGetDevice(&dev);
    (void)hipDeviceGetAttribute(&cus, hipDeviceAttributeMultiprocessorCount, dev);
    (void)hipOccupancyMaxActiveBlocksPerMultiprocessor(&per_cu, mega, 256, 0);
    if (per_cu > 2) per_cu = 2;
    if (per_cu < 1) per_cu = 1;
    grid_blocks = cus * per_cu;
  }
  if (ws_size < WS_END) fprintf(stderr, "workspace too small: %zu < %zu\n", ws_size, (size_t)WS_END);
  Params p{};
  for (int i = 0; i < 37; ++i) p.in[i] = (const float*)d_in[i];
  p.out = (float*)d_out;
  p.ws = (unsigned char*)d_ws;
  (void)hipMemsetAsync(d_ws, 0, 4096 + 16384, stream);
  void* args[] = {&p};
  hipError_t e = hipLaunchCooperativeKernel((void*)mega, dim3(grid_blocks), dim3(256), args, 0, stream);
  if (e != hipSuccess) fprintf(stderr, "coop launch failed: %s\n", hipGetErrorString(e));
}
```

```cpp
#include <hip/hip_runtime.h>
#include <hip/hip_cooperative_groups.h>
#include <cstdio>
namespace cg = cooperative_groups;

typedef unsigned short bf16_t;
typedef short bf16x8 __attribute__((ext_vector_type(8)));
typedef float f32x4 __attribute__((ext_vector_type(4)));
typedef unsigned u32x4 __attribute__((ext_vector_type(4)));
typedef unsigned u32x2 __attribute__((ext_vector_type(2)));
#define DI __device__ __forceinline__

constexpr int DM = 1024, TP = 16384, TS = 2048, MT = 18432;
constexpr int RC = 1792, MIXC = 3072, DFF = 2816;
constexpr int C_R = 0, C_K = 512, C_V = 1024, C_X = 1536, C_Q = 1792, C_SK = 2304, C_SV = 2432, C_QM = 2560;
constexpr float RMS_EPS = 1e-6f, GN_EPS = 64e-5f;

constexpr size_t O_Y = 0;
constexpr size_t O_SWK_P = (size_t)MT * DM;
constexpr size_t O_SWV_P = O_SWK_P + 131072;
constexpr size_t O_MK_P = O_SWV_P + 131072;
constexpr size_t O_MV_P = O_MK_P + 1048576;
constexpr size_t O_RW_P = O_MV_P + 1048576;
constexpr size_t O_SH_P = O_RW_P + 262144;
constexpr size_t O_CV_P = O_SH_P + 14336;
constexpr size_t O_SWK_S = O_CV_P + 45056;
constexpr size_t O_SWV_S = O_SWK_S + 1048576;
constexpr size_t O_RW_S = O_SWV_S + 1048576;
constexpr size_t O_SH_S = O_RW_S + 2097152;
constexpr size_t O_CV_S = O_SH_S + 114688;

constexpr size_t WS_CTR = 0;
constexpr size_t WS_BAR = 4096;
constexpr size_t WS_RS1 = 4096 + 16384;
constexpr size_t WS_RS2 = WS_RS1 + 73728;
constexpr size_t WS_RSM = WS_RS2 + 73728;
constexpr size_t WS_BON = WS_RSM + 4096;
constexpr size_t WS_WIN = WS_BON + 589824;
constexpr size_t WS_WUP = WS_WIN + 12582912;
constexpr size_t WS_WDN = WS_WUP + 11534336;
constexpr size_t WS_WBR = WS_WDN + 5767168;
constexpr size_t WS_WOUT = WS_WBR + 3145728;
constexpr size_t WS_WMKV = WS_WOUT + 2097152;
constexpr size_t WS_WW2 = WS_WMKV + 2097152;
constexpr size_t WS_WA2 = WS_WW2 + 65536;
constexpr size_t WS_WG2 = WS_WA2 + 65536;
constexpr size_t WS_P = WS_WG2 + 131072;
constexpr size_t WS_R = WS_P + 113246208;
constexpr size_t WS_LD = WS_R;
constexpr size_t WS_AA = WS_LD + 18874368;
constexpr size_t WS_LIN = WS_AA + 18874368;
constexpr size_t WS_OA = WS_LIN + 9437184;
constexpr size_t WS_OB = WS_OA + 18874368;
constexpr size_t WS_OM = WS_OB + 18874368;
constexpr size_t WS_VSP = WS_R + 103809024;
constexpr int VSP_LD = 4224;
constexpr size_t WS_VSS = WS_VSP + (size_t)4 * 2 * 64 * VSP_LD * 2;
constexpr size_t WS_VM = WS_VSS + (size_t)32 * 2 * 64 * 192 * 2;
constexpr size_t WS_XB = WS_VM + (size_t)36 * 4 * 128 * 256 * 2;
constexpr size_t WS_END = WS_XB + (size_t)(MT + 1024) * 1024 * 2;

struct Params {
  const float* in[37];
  float* out;
  unsigned char* ws;
};
typedef const __attribute__((address_space(4))) Params* PP;

DI int tidx() { int t = __builtin_amdgcn_workitem_id_x(); asm volatile("" : "+v"(t)); return t; }
DI float bf2f(bf16_t h) { return __uint_as_float(((unsigned)h) << 16); }
typedef float f32x2 __attribute__((ext_vector_type(2)));
typedef __bf16 bf16v2 __attribute__((ext_vector_type(2)));
DI unsigned pack2(float lo, float hi) { f32x2 v = {lo, hi}; bf16v2 b = __builtin_convertvector(v, bf16v2); return __builtin_bit_cast(unsigned, b); }
DI bf16_t f2bf(float x) { return (bf16_t)(pack2(x, 0.f) & 0xffffu); }
DI float lo16(unsigned u) { return __uint_as_float(u << 16); }
DI float hi16(unsigned u) { return __uint_as_float(u & 0xffff0000u); }
DI float sigmoidf_(float x) { return __builtin_amdgcn_rcpf(1.f + __expf(-x)); }
DI int tok_t(int m) { return m < TP ? (m & 4095) : (m & 63); }
DI int tok_b(int m) { return m < TP ? (m >> 12) : ((m - TP) >> 6); }
DI const float* xrow(const PP p, int l, int m) {
  return l == 0 ? (m < TP ? p->in[0] + (size_t)m * DM : p->in[1] + (size_t)(m - TP) * DM) : p->out + (size_t)m * DM;
}
DI float shift_in(const PP p, int l, int m, int c) {
  return m < TP ? 0.f : p->in[7][((size_t)l * 32 + ((m - TP) >> 6)) * RC + c];
}
DI float wave_sum(float v) {
#pragma unroll
  for (int o = 32; o > 0; o >>= 1) v += __shfl_xor(v, o);
  return v;
}
template <int CTRL> DI float dpp_add(float x) {
  return x + __int_as_float(__builtin_amdgcn_update_dpp(0, __float_as_int(x), CTRL, 0xf, 0xf, true));
}
DI float allreduce16(float x) {
  x = dpp_add<0xB1>(x);
  x = dpp_add<0x4E>(x);
  x = dpp_add<0x141>(x);
  x = dpp_add<0x140>(x);
  return x;
}
DI bf16x8 cvt8(f32x4 a, f32x4 b) {
  u32x4 r; r[0] = pack2(a[0], a[1]); r[1] = pack2(a[2], a[3]); r[2] = pack2(b[0], b[1]); r[3] = pack2(b[2], b[3]);
  return __builtin_bit_cast(bf16x8, r);
}
#define MFMA16(a, b, c) __builtin_amdgcn_mfma_f32_16x16x32_bf16((a), (b), (c), 0, 0, 0)

constexpr int LSTR = 144;
typedef const void __attribute__((address_space(1)))* gptr_t;
typedef void __attribute__((address_space(3)))* lptr_t;
template <int MI, int NJ>
DI void gemm_acc(f32x4 (&acc)[MI][NJ], const bf16_t* Ap, int lda, const bf16_t* Bt, int ldb, int K, unsigned char* smem) {
  const int tid = tidx(), lane = tid & 63, w = tid >> 6, wm = w >> 1, wn = w & 1, l15 = lane & 15, quad = lane >> 4;
  constexpr int AROWS = MI * 32, BROWS = NJ * 32, STAGE = (AROWS + BROWS) * 128;
  const int nk = K >> 6;
  const int r_in = lane >> 3, ch = (lane & 7) ^ r_in;
  const bf16_t* ag = Ap + (size_t)(w * 8 + r_in) * lda + ch * 8;
  const bf16_t* bg = Bt + (size_t)(w * 8 + r_in) * ldb + ch * 8;
  unsigned char* dma = smem + w * 1024;
  auto issue = [&](int kt, int st) {
    unsigned char* sa = dma + st * STAGE;
#pragma unroll
    for (int i = 0; i < MI; ++i)
      __builtin_amdgcn_global_load_lds((gptr_t)(ag + (size_t)(i * 32) * lda + kt * 64), (lptr_t)(sa + i * 4096), 16, 0, 0);
#pragma unroll
    for (int i = 0; i < NJ; ++i)
      __builtin_amdgcn_global_load_lds((gptr_t)(bg + (size_t)(i * 32) * ldb + kt * 64), (lptr_t)(sa + AROWS * 128 + i * 4096), 16, 0, 0);
  };
  const int ro0 = (quad ^ (l15 & 7)) * 16, ro1 = ro0 ^ 64;
  const unsigned char* rA = smem + (wm * MI * 16 + l15) * 128;
  const unsigned char* rB = smem + AROWS * 128 + (wn * NJ * 16 + l15) * 128;
  __syncthreads();
  issue(0, 0);
  for (int kt = 0; kt < nk; ++kt) {
    asm volatile("s_waitcnt vmcnt(0)" ::: "memory");
    __syncthreads();
    const int so = (kt & 1) * STAGE;
    bf16x8 fb0[NJ], fa0[MI], fb1[NJ], fa1[MI];
#pragma unroll
    for (int j = 0; j < NJ; ++j) fb0[j] = *(const bf16x8*)(rB + so + j * 2048 + ro0);
#pragma unroll
    for (int i = 0; i < MI; ++i) fa0[i] = *(const bf16x8*)(rA + so + i * 2048 + ro0);
#pragma unroll
    for (int j = 0; j < NJ; ++j) fb1[j] = *(const bf16x8*)(rB + so + j * 2048 + ro1);
#pragma unroll
    for (int i = 0; i < MI; ++i) fa1[i] = *(const bf16x8*)(rA + so + i * 2048 + ro1);
    __builtin_amdgcn_sched_barrier(0);
    if (kt + 1 < nk) issue(kt + 1, (kt + 1) & 1);
    __builtin_amdgcn_sched_barrier(0);
#pragma unroll
    for (int i = 0; i < MI; ++i)
#pragma unroll
      for (int j = 0; j < NJ; ++j) acc[i][j] = MFMA16(fb0[j], fa0[i], acc[i][j]);
#pragma unroll
    for (int i = 0; i < MI; ++i)
#pragma unroll
      for (int j = 0; j < NJ; ++j) acc[i][j] = MFMA16(fb1[j], fa1[i], acc[i][j]);
  }
}
template <int MI, int NJ> DI void zero_acc(f32x4 (&acc)[MI][NJ]) {
#pragma unroll
  for (int i = 0; i < MI; ++i)
#pragma unroll
    for (int j = 0; j < NJ; ++j) acc[i][j] = (f32x4){0.f, 0.f, 0.f, 0.f};
}
#define EPI_IDX(MI_, NJ_)                                                                         \
  const int tid_ = tidx(), lane_ = tid_ & 63, w_ = tid_ >> 6, wm_ = w_ >> 1, wn_ = w_ & 1;         \
  const int l15_ = lane_ & 15, quad_ = lane_ >> 4;                                                 \
  const int mb_ = m0 + wm_ * (MI_) * 16 + l15_, nb_ = n0 + wn_ * (NJ_) * 16 + quad_ * 4;

template <int NJ>
DI void store_tile(const u32x2 (&ov)[4][NJ], bf16_t* dst, size_t ld, int m0, int n0, unsigned char* smem) {
  const int tid = tidx(), lane = tid & 63, w = tid >> 6, wm = w >> 1, wn = w & 1, l15 = lane & 15, quad = lane >> 4;
  constexpr int RS = NJ * 64 + 16;
  __syncthreads();
#pragma unroll
  for (int i = 0; i < 4; ++i)
#pragma unroll
    for (int j = 0; j < NJ; ++j)
      *(u32x2*)(smem + (wm * 64 + i * 16 + l15) * RS + (wn * NJ * 16 + j * 16 + quad * 4) * 2) = ov[i][j];
  __syncthreads();
  constexpr int CPR = NJ * 4;
#pragma unroll
  for (int k = 0; k < (128 * CPR) / 256; ++k) {
    const int c = tid + k * 256, row = c / CPR, ch = c % CPR;
    const u32x4 v = *(const u32x4*)(smem + row * RS + ch * 16);
    *(u32x4*)(dst + (size_t)(m0 + row) * ld + n0 + ch * 8) = v;
  }
}

template <int NJ>
DI void tile_flush(bf16_t* dst, size_t ld, int m0, int n0, unsigned char* smem) {
  const int tid = tidx();
  constexpr int RS = NJ * 64 + 16, CPR = NJ * 4;
  __syncthreads();
#pragma unroll
  for (int k = 0; k < (128 * CPR) / 256; ++k) {
    const int c = tid + k * 256, row = c / CPR, ch = c % CPR;
    const u32x4 v = *(const u32x4*)(smem + row * RS + ch * 16);
    *(u32x4*)(dst + (size_t)(m0 + row) * ld + n0 + ch * 8) = v;
  }
}

DI bool conv_desc(const PP p, int l, int t, const float*& src, bf16_t*& dst, int& K, int& N, const float*& sc, int& lt) {
  int base = 0;
#define MAT(SRC, DST, KK, NN, SC)                                                               \
  {                                                                                             \
    const int nt = ((KK) / 64) * ((NN) / 64);                                                   \
    if (t < base + nt) { src = (SRC); dst = (bf16_t*)(p->ws + (DST)); K = (KK); N = (NN); sc = (SC); lt = t - base; return true; } \
    base += nt;                                                                                 \
  }
  MAT(p->in[11] + (size_t)l * 1024 * 6144, WS_WIN, 1024, 6144, p->in[10] + l * 1024)
  MAT(p->in[33] + (size_t)l * 1024 * 5632, WS_WUP, 1024, 5632, p->in[32] + l * 1024)
  MAT(p->in[36] + (size_t)l * 2816 * 1024, WS_WDN, 2816, 1024, nullptr)
  MAT(p->in[30] + (size_t)(l * 3 + 0) * 512 * 1024, WS_WBR, 512, 1024, nullptr)
  MAT(p->in[30] + (size_t)(l * 3 + 1) * 512 * 1024, WS_WBR + 1048576, 512, 1024, nullptr)
  MAT(p->in[30] + (size_t)(l * 3 + 2) * 512 * 1024, WS_WBR + 2097152, 512, 1024, nullptr)
  MAT(p->in[31] + (size_t)l * 1024 * 1024, WS_WOUT, 1024, 1024, nullptr)
  MAT(p->in[27] + (size_t)l * 1024 * 1024, WS_WMKV, 1024, 1024, p->in[26] + l * 1024)
  MAT(p->in[14] + (size_t)l * 64 * 512, WS_WW2, 64, 512, nullptr)
  MAT(p->in[16] + (size_t)l * 64 * 512, WS_WA2, 64, 512, nullptr)
  MAT(p->in[17] + (size_t)l * 128 * 512, WS_WG2, 128, 512, nullptr)
#undef MAT
  return false;
}
constexpr int CONV_TILES = 16 * 96 + 16 * 88 + 44 * 16 + 3 * 8 * 16 + 256 + 256 + 8 + 8 + 16;

DI void row_stats3(const float* s0, const float* s1, const float* s2, float* d0, float* d1, float* d2, bf16_t* x0, bf16_t* x1, bf16_t* x2, int lane) {
  f32x4 v[3][4];
#pragma unroll
  for (int i = 0; i < 4; ++i) {
    v[0][i] = *(const f32x4*)(s0 + (i * 64 + lane) * 4);
    if (s1) v[1][i] = *(const f32x4*)(s1 + (i * 64 + lane) * 4);
    if (s2) v[2][i] = *(const f32x4*)(s2 + (i * 64 + lane) * 4);
  }
  const float* sp[3] = {s0, s1, s2};
  float* dp[3] = {d0, d1, d2};
  bf16_t* xp[3] = {x0, x1, x2};
#pragma unroll
  for (int r = 0; r < 3; ++r) {
    if (!sp[r]) continue;
    float ss = 0.f;
#pragma unroll
    for (int i = 0; i < 4; ++i) {
      const f32x4 a = v[r][i];
      ss += a[0] * a[0] + a[1] * a[1] + a[2] * a[2] + a[3] * a[3];
      u32x2 o; o[0] = pack2(a[0], a[1]); o[1] = pack2(a[2], a[3]);
      *(u32x2*)(xp[r] + (i * 64 + lane) * 4) = o;
    }
    ss = wave_sum(ss);
    if (lane == 0) *dp[r] = rsqrtf(ss * (1.f / 1024.f) + RMS_EPS);
  }
}

DI void phase_convert(const PP p, int l, unsigned char* smem) {
  float* lds = (float*)smem;
  const int tid = tidx();
  {
    const float* src; bf16_t* dst; int K, N, lt; const float* sc;
    f32x4 v[4];
    float sv[4];
    int t = blockIdx.x, k0 = 0, n0 = 0;
    auto fetch = [&](int tt) {
      conv_desc(p, l, tt, src, dst, K, N, sc, lt);
      const int ntn = N >> 6;
      k0 = (lt / ntn) * 64; n0 = (lt % ntn) * 64;
#pragma unroll
      for (int ps = 0; ps < 4; ++ps) {
        const int r = ps * 16 + (tid >> 4), c = (tid & 15) * 4;
        v[ps] = *(const f32x4*)(src + (size_t)(k0 + r) * N + n0 + c);
        sv[ps] = sc ? sc[k0 + r] : 1.f;
      }
    };
    if (t < CONV_TILES) fetch(t);
    while (t < CONV_TILES) {
      __syncthreads();
#pragma unroll
      for (int ps = 0; ps < 4; ++ps) {
        const int r = ps * 16 + (tid >> 4), c = (tid & 15) * 4;
        const float s = sv[ps];
        lds[r * 65 + c] = v[ps][0] * s; lds[r * 65 + c + 1] = v[ps][1] * s; lds[r * 65 + c + 2] = v[ps][2] * s; lds[r * 65 + c + 3] = v[ps][3] * s;
      }
      __syncthreads();
      bf16_t* dcur = dst; const int Kc = K, k0c = k0, n0c = n0;
      const int tn = t + gridDim.x;
      if (tn < CONV_TILES) fetch(tn);
#pragma unroll
      for (int e = 0; e < 2; ++e) {
        const int idx = tid + e * 256, n = idx >> 3, kg = idx & 7;
        u32x4 o;
#pragma unroll
        for (int i = 0; i < 4; ++i) o[i] = pack2(lds[(kg * 8 + 2 * i) * 65 + n], lds[(kg * 8 + 2 * i + 1) * 65 + n]);
        *(u32x4*)(dcur + (size_t)(n0c + n) * Kc + k0c + kg * 8) = o;
      }
      t = tn;
    }
  }
  const int lane = tid & 63, gw = blockIdx.x * 4 + (tid >> 6), nw = gridDim.x * 4;
  float* rs1 = (float*)(p->ws + WS_RS1);
  float* rsm = (float*)(p->ws + WS_RSM);
  bf16_t* XB = (bf16_t*)(p->ws + WS_XB);
  auto srcrow = [&](int row) -> const float* { return row >= MT + 1024 ? nullptr : (row < MT ? xrow(p, l, row) : p->in[9] + (size_t)(row - MT) * 1024); };
  auto dstrow = [&](int row) -> float* { return row < MT ? rs1 + row : rsm + (row - MT); };
  for (int row = gw; row < MT + 1024; row += 3 * nw)
    row_stats3(srcrow(row), srcrow(row + nw), srcrow(row + 2 * nw), dstrow(row), dstrow(row + nw), dstrow(row + 2 * nw),
               XB + (size_t)row * 1024, XB + (size_t)(row + nw) * 1024, XB + (size_t)(row + 2 * nw) * 1024, lane);
}

DI void phase_stats2(const PP p) {
  const int tid = tidx(), lane = tid & 63, gw = blockIdx.x * 4 + (tid >> 6), nw = gridDim.x * 4;
  float* rs2 = (float*)(p->ws + WS_RS2);
  bf16_t* XB = (bf16_t*)(p->ws + WS_XB);
  auto srcrow = [&](int row) -> const float* { return row >= MT ? nullptr : p->out + (size_t)row * DM; };
  for (int row = gw; row < MT; row += 3 * nw)
    row_stats3(srcrow(row), srcrow(row + nw), srcrow(row + 2 * nw), rs2 + row, rs2 + row + nw, rs2 + row + 2 * nw,
               XB + (size_t)row * 1024, XB + (size_t)(row + nw) * 1024, XB + (size_t)(row + 2 * nw) * 1024, lane);
}

DI void phase_gemm_in(const PP p, int l, unsigned char* smem) {
  bf16_t* P = (bf16_t*)(p->ws + WS_P);
  const float* rs1 = (const float*)(p->ws + WS_RS1);
  const float* rsm = (const float*)(p->ws + WS_RSM);
  const int NT1 = 144 * 24;
  for (int t = blockIdx.x; t < NT1 + 64; t += gridDim.x) {
    f32x4 acc[4][4];
    zero_acc<4, 4>(acc);
    if (t < NT1) {
      const int m0 = (t / 24) * 128, n0 = (t % 24) * 128;
      gemm_acc<4, 4>(acc, (const bf16_t*)(p->ws + WS_XB) + (size_t)m0 * 1024, 1024, (const bf16_t*)(p->ws + WS_WIN) + (size_t)n0 * 1024, 1024, 1024, smem);
      EPI_IDX(4, 4)
      u32x2 ov[4][4];
#pragma unroll
      for (int i = 0; i < 4; ++i) {
        const int m = mb_ + i * 16;
        const float rs = rs1[m];
        const int t_ = tok_t(m);
        const bool last = m < TP ? (t_ == 4095) : (t_ == 63);
#pragma unroll
        for (int j = 0; j < 4; ++j) {
          const int n = nb_ + j * 16;
          f32x4 v = acc[i][j] * rs;
          u32x2 o; o[0] = pack2(v[0], v[1]); o[1] = pack2(v[2], v[3]);
          ov[i][j] = o;
          if (last && n < RC) {
            float* so = m < TP ? p->out + O_SH_P + ((size_t)l * 4 + (m >> 12)) * RC + n : p->out + O_SH_S + ((size_t)l * 32 + ((m - TP) >> 6)) * RC + n;
            *(f32x4*)so = v;
          }
        }
      }
      store_tile<4>(ov, P, MIXC, m0, n0, smem);
    } else {
      const int tt = t - NT1, m0 = (tt >> 3) * 128, n0 = (tt & 7) * 128;
      gemm_acc<4, 4>(acc, (const bf16_t*)(p->ws + WS_XB) + (size_t)(MT + m0) * 1024, 1024, (const bf16_t*)(p->ws + WS_WMKV) + (size_t)n0 * 1024, 1024, 1024, smem);
      EPI_IDX(4, 4)
#pragma unroll
      for (int i = 0; i < 4; ++i) {
        const int m = mb_ + i * 16;
        const float rs = rsm[m];
#pragma unroll
        for (int j = 0; j < 4; ++j) {
          const int n = nb_ + j * 16;
          f32x4 v = acc[i][j] * rs;
          float* dst = n < 512 ? p->out + O_MK_P + ((size_t)l * 1024 + m) * 512 + n : p->out + O_MV_P + ((size_t)l * 1024 + m) * 512 + (n - 512);
          *(f32x4*)dst = v;
        }
      }
    }
  }
}

DI void phase_prep(const PP p, int l, int part) {
  bf16_t* P = (bf16_t*)(p->ws + WS_P);
  const int g0 = blockIdx.x * 256 + tidx(), G = gridDim.x * 256;
  if (part == 0) {
    bf16_t* LIN = (bf16_t*)(p->ws + WS_LIN);
    const float* mu = p->in[12] + l * RC;
    for (int idx = g0; idx < MT * 32; idx += G) {
      const int m = idx >> 5, c8 = (idx & 31) * 8, t = tok_t(m);
      u32x4 cur = *(const u32x4*)(P + (size_t)m * MIXC + C_X + c8);
      u32x4 prv = (u32x4){0u, 0u, 0u, 0u};
      if (t > 0) prv = *(const u32x4*)(P + (size_t)(m - 1) * MIXC + C_X + c8);
      u32x4 o;
#pragma unroll
      for (int i = 0; i < 4; ++i) {
        float c0 = lo16(cur[i]), c1 = hi16(cur[i]);
        float p0, p1;
        if (t > 0) { p0 = lo16(prv[i]); p1 = hi16(prv[i]); }
        else { p0 = shift_in(p, l, m, C_X + c8 + 2 * i); p1 = shift_in(p, l, m, C_X + c8 + 2 * i + 1); }
        float v0 = c0 + (p0 - c0) * mu[C_X + c8 + 2 * i], v1 = c1 + (p1 - c1) * mu[C_X + c8 + 2 * i + 1];
        if (c8 < 64) { v0 = 2.f * sigmoidf_(2.f * v0) - 1.f; v1 = 2.f * sigmoidf_(2.f * v1) - 1.f; }
        else if (c8 >= 128) { v0 = sigmoidf_(v0); v1 = sigmoidf_(v1); }
        o[i] = pack2(v0, v1);
      }
      *(u32x4*)(LIN + (size_t)m * 256 + c8) = o;
    }
  }
  if (part == 0) return;
  {
    const float* kg = p->in[24] + l * 64;
    for (int idx = g0; idx < MT * 2; idx += G) {
      const int m = idx >> 1, kvh = idx & 1, t = tok_t(m), b = tok_b(m);
      bf16_t* kp = P + (size_t)m * MIXC + C_SK + kvh * 64;
      float ss = 0.f;
#pragma unroll
      for (int i = 0; i < 8; ++i) {
        u32x4 v = *(const u32x4*)(kp + i * 8);
#pragma unroll
        for (int e = 0; e < 4; ++e) { float a = lo16(v[e]), c = hi16(v[e]); ss += a * a + c * c; }
      }
      const float rs = rsqrtf(ss * (1.f / 64.f) + RMS_EPS);
      float* ko = nullptr;
      if (m < TP) { if (t >= 3968) ko = p->out + O_SWK_P + (((size_t)l * 4 + b) * 128 + (t - 3968)) * 128 + kvh * 64; }
      else ko = p->out + O_SWK_S + (((size_t)l * 32 + b) * 128 + 64 + t) * 128 + kvh * 64;
#pragma unroll
      for (int i = 0; i < 8; ++i) {
        u32x4 v = *(const u32x4*)(kp + i * 8);
        u32x4 o;
#pragma unroll
        for (int e = 0; e < 4; ++e) {
          float a = lo16(v[e]) * rs * kg[i * 8 + 2 * e], c = hi16(v[e]) * rs * kg[i * 8 + 2 * e + 1];
          o[e] = pack2(a, c);
          if (ko) { ko[i * 8 + 2 * e] = a; ko[i * 8 + 2 * e + 1] = c; }
        }
        *(u32x4*)(kp + i * 8) = o;
      }
    }
  }
  {
    for (int idx = g0; idx < 4 * 128 * 128; idx += G) {
      const int c = idx & 127, j = (idx >> 7) & 127, b = idx >> 14;
      p->out[O_SWV_P + (((size_t)l * 4 + b) * 128 + j) * 128 + c] = bf2f(P[(size_t)(b * 4096 + 3968 + j) * MIXC + C_SV + c]);
    }
    for (int idx = g0; idx < 32 * 128 * 128; idx += G) {
      const int c = idx & 127, j = (idx >> 7) & 127, b = idx >> 14;
      const size_t o = (((size_t)l * 32 + b) * 128 + j) * 128 + c;
      if (j < 64) {
        const size_t s = (((size_t)l * 32 + b) * 128 + 64 + j) * 128 + c;
        p->out[O_SWK_S + o] = p->in[2][s];
        p->out[O_SWV_S + o] = p->in[3][s];
      } else {
        p->out[O_SWV_S + o] = bf2f(P[(size_t)(TP + b * 64 + (j - 64)) * MIXC + C_SV + c]);
      }
    }
  }
  {
    bf16_t* VSP = (bf16_t*)(p->ws + WS_VSP);
    for (int idx = g0; idx < 8 * 528 * 64; idx += G) {
      const int d = idx & 63, rest = idx >> 6, c8 = (rest % 528) * 8, bk = rest / 528, b = bk >> 1, kvh = bk & 1;
      u32x4 o = (u32x4){0u, 0u, 0u, 0u};
      if (c8 >= 128) {
        const bf16_t* s = P + (size_t)(b * 4096 + c8 - 128) * MIXC + C_SV + kvh * 64 + d;
#pragma unroll
        for (int i = 0; i < 4; ++i) o[i] = (unsigned)s[(size_t)(2 * i) * MIXC] | ((unsigned)s[(size_t)(2 * i + 1) * MIXC] << 16);
      }
      *(u32x4*)(VSP + ((size_t)bk * 64 + d) * VSP_LD + c8) = o;
    }
    bf16_t* VSS = (bf16_t*)(p->ws + WS_VSS);
    for (int idx = g0; idx < 64 * 24 * 64; idx += G) {
      const int d = idx & 63, rest = idx >> 6, c8 = (rest % 24) * 8, bk = rest / 24, b = bk >> 1, kvh = bk & 1;
      u32x4 o;
      if (c8 < 128) {
        const float* s = p->in[3] + (((size_t)l * 32 + b) * 128 + c8) * 128 + kvh * 64 + d;
#pragma unroll
        for (int i = 0; i < 4; ++i) o[i] = pack2(s[(2 * i) * 128], s[(2 * i + 1) * 128]);
      } else {
        const bf16_t* s = P + (size_t)(TP + b * 64 + c8 - 128) * MIXC + C_SV + kvh * 64 + d;
#pragma unroll
        for (int i = 0; i < 4; ++i) o[i] = (unsigned)s[(size_t)(2 * i) * MIXC] | ((unsigned)s[(size_t)(2 * i + 1) * MIXC] << 16);
      }
      *(u32x4*)(VSS + ((size_t)bk * 64 + d) * 192 + c8) = o;
    }
    bf16_t* VM = (bf16_t*)(p->ws + WS_VM);
    for (int idx = g0; idx < 144 * 32 * 128; idx += G) {
      const int d = idx & 127, rest = idx >> 7, m8 = (rest & 31) * 8, bh = rest >> 5, bb = bh >> 2, h = bh & 3;
      const float* s = bb < 4 ? p->out + O_MV_P + (((size_t)l * 4 + bb) * 256 + m8) * 512 + h * 128 + d
                              : p->in[5] + (((size_t)l * 32 + (bb - 4)) * 256 + m8) * 512 + h * 128 + d;
      u32x4 o;
#pragma unroll
      for (int i = 0; i < 4; ++i) o[i] = pack2(s[(2 * i) * 512], s[(2 * i + 1) * 512]);
      *(u32x4*)(VM + ((size_t)bh * 128 + d) * 256 + m8) = o;
    }
  }
  {
    const float* kg = p->in[29] + l * 128;
    for (int idx = g0; idx < 4096; idx += G) {
      float* kp = p->out + O_MK_P + (size_t)l * 1024 * 512 + (size_t)idx * 128;
      float ss = 0.f;
#pragma unroll 4
      for (int i = 0; i < 32; ++i) { f32x4 v = *(const f32x4*)(kp + i * 4); ss += v[0] * v[0] + v[1] * v[1] + v[2] * v[2] + v[3] * v[3]; }
      const float rs = rsqrtf(ss * (1.f / 128.f) + RMS_EPS);
#pragma unroll 4
      for (int i = 0; i < 32; ++i) {
        f32x4 v = *(const f32x4*)(kp + i * 4);
        f32x4 g = *(const f32x4*)(kg + i * 4);
        *(f32x4*)(kp + i * 4) = v * rs * g;
      }
    }
  }
}

DI void phase_lora(const PP p, int l, unsigned char* smem) {
  const bf16_t* LIN = (const bf16_t*)(p->ws + WS_LIN);
  for (int t = blockIdx.x; t < 144 * 4 * 2; t += gridDim.x) {
    const int which = t / 576, tt = t % 576, m0 = (tt >> 2) * 128, n0 = (tt & 3) * 128;
    f32x4 acc[4][4];
    zero_acc<4, 4>(acc);
    gemm_acc<4, 4>(acc, LIN + (size_t)m0 * 256 + which * 64, 256, (const bf16_t*)(p->ws + (which ? WS_WA2 : WS_WW2)) + (size_t)n0 * 64, 64, 64, smem);
    bf16_t* dst = (bf16_t*)(p->ws + (which ? WS_AA : WS_LD));
    const float* bias = (which ? p->in[15] : p->in[13]) + l * 512;
    EPI_IDX(4, 4)
    u32x2 ov[4][4];
#pragma unroll
    for (int i = 0; i < 4; ++i) {
      const int m = mb_ + i * 16;
#pragma unroll
      for (int j = 0; j < 4; ++j) {
        const int n = nb_ + j * 16;
        f32x4 bv = *(const f32x4*)(bias + n);
        f32x4 v = acc[i][j] + bv;
#pragma unroll
        for (int r = 0; r < 4; ++r) {
          if (which) v[r] = sigmoidf_(v[r]);
          else v[r] = -0.6065306597126334f * sigmoidf_(v[r]);
        }
        ov[i][j][0] = pack2(v[0], v[1]); ov[i][j][1] = pack2(v[2], v[3]);
      }
    }
    store_tile<4>(ov, dst, 512, m0, n0, smem);
  }
}

DI void gates_tile(const PP p, int l, int m0, int n0, unsigned char* smem) {
  const float* rs1 = (const float*)(p->ws + WS_RS1);
  const bool early = n0 < 2048;
  bf16_t* G = early ? (bf16_t*)p->out : (bf16_t*)(p->ws + WS_P);
  const size_t ldg = early ? 2048 : MIXC;
  f32x4 acc[4][4];
  zero_acc<4, 4>(acc);
  gemm_acc<4, 4>(acc, (const bf16_t*)(p->ws + WS_XB) + (size_t)m0 * 1024, 1024, (const bf16_t*)(p->ws + WS_WIN) + (size_t)(MIXC + n0) * 1024, 1024, 1024, smem);
  EPI_IDX(4, 4)
  u32x2 ov[4][4];
#pragma unroll
  for (int i = 0; i < 4; ++i) {
    const float rs = rs1[mb_ + i * 16];
#pragma unroll
    for (int j = 0; j < 4; ++j) {
      f32x4 v = acc[i][j] * rs;
      ov[i][j][0] = pack2(sigmoidf_(v[0]), sigmoidf_(v[1])); ov[i][j][1] = pack2(sigmoidf_(v[2]), sigmoidf_(v[3]));
    }
  }
  store_tile<4>(ov, G, ldg, m0, n0, smem);
}

constexpr int TC = 32;
template <int CTRL> DI float dpp_mov(float x) {
  return __int_as_float(__builtin_amdgcn_update_dpp(0, __float_as_int(x), CTRL, 0xf, 0xf, true));
}
DI float allreduce8(float x) {
  x = dpp_add<0xB1>(x);
  x = dpp_add<0x4E>(x);
  x = dpp_add<0x141>(x);
  return x;
}
DI void unpack8(u32x4 v, float (&f)[8]) {
#pragma unroll
  for (int e = 0; e < 4; ++e) { f[2 * e] = lo16(v[e]); f[2 * e + 1] = hi16(v[e]); }
}
DI void rwkv_unit(const PP p, int l, int grp, int b, int h, int rg, unsigned char* smem) {
  const bf16_t* P = (const bf16_t*)(p->ws + WS_P);
  const bf16_t* LD = (const bf16_t*)(p->ws + WS_LD);
  const bf16_t* AA = (const bf16_t*)(p->ws + WS_AA);
  bf16_t* OA = (bf16_t*)(p->ws + WS_OA);
  float* BON = (float*)(p->ws + WS_BON);
  float* sr = (float*)smem;
  float* sw = sr + TC * 64;
  float* sk = sw + TC * 64;
  float* skk = sk + TC * 64;
  float* sb = skk + TC * 64;
  float* sv = sb + TC * 64;
  const int tid = tidx();
  const int row = tid >> 4, kq = tid & 15;
  const int stt = tid >> 3, kg = tid & 7;
  const int T = grp ? 64 : 4096;
  const int mbase = grp ? TP + b * 64 : b * 4096;
  const int vrow = rg * 16 + row;
  f32x4 S = (f32x4){0.f, 0.f, 0.f, 0.f};
  if (grp) S = *(const f32x4*)(p->in[6] + ((((size_t)l * 32 + b) * 8 + h) * 64 + vrow) * 64 + kq * 4);
  const int c0 = h * 64 + kg * 8;
  u32x4 cR, cK, cV, pR, pK, pV, aA, aL;
  auto issue = [&](int t0) {
    const int m = mbase + t0 + stt;
    const bf16_t* pr = P + (size_t)m * MIXC + c0;
    cR = *(const u32x4*)(pr + C_R); cK = *(const u32x4*)(pr + C_K); cV = *(const u32x4*)(pr + C_V);
    const bf16_t* pp = (t0 + stt > 0) ? pr - MIXC : pr;
    pR = *(const u32x4*)(pp + C_R); pK = *(const u32x4*)(pp + C_K); pV = *(const u32x4*)(pp + C_V);
    aA = *(const u32x4*)(AA + (size_t)m * 512 + c0);
    aL = *(const u32x4*)(LD + (size_t)m * 512 + c0);
  };
  issue(0);
  for (int t0 = 0; t0 < T; t0 += TC) {
    {
      const int t = t0 + stt, m = mbase + t;
      float fr[8], fk[8], fv[8], qr[8], qk[8], qv[8], fa[8], fl[8];
      unpack8(cR, fr); unpack8(cK, fk); unpack8(cV, fv);
      unpack8(pR, qr); unpack8(pK, qk); unpack8(pV, qv);
      unpack8(aA, fa); unpack8(aL, fl);
      if (t == 0) {
#pragma unroll
        for (int e = 0; e < 8; ++e) { qr[e] = shift_in(p, l, m, C_R + c0 + e); qk[e] = shift_in(p, l, m, C_K + c0 + e); qv[e] = shift_in(p, l, m, C_V + c0 + e); }
      }
      const float* mu = p->in[12] + l * RC;
      const float* kkw = p->in[18] + l * 512 + c0;
      const float* kaw = p->in[19] + l * 512 + c0;
      const float* rkw = p->in[20] + l * 512 + c0;
      float nn = 0.f, bn = 0.f;
      float kkv[8], km[8];
#pragma unroll
      for (int e = 0; e < 8; ++e) {
        fr[e] = fr[e] + (qr[e] - fr[e]) * mu[C_R + c0 + e];
        fk[e] = fk[e] + (qk[e] - fk[e]) * mu[C_K + c0 + e];
        fv[e] = fv[e] + (qv[e] - fv[e]) * mu[C_V + c0 + e];
        kkv[e] = fk[e] * kkw[e];
        nn += kkv[e] * kkv[e];
        km[e] = fk[e] * (1.f + (fa[e] - 1.f) * kaw[e]);
        bn += fr[e] * km[e] * rkw[e];
      }
      nn = allreduce8(nn);
      const float inv = __builtin_amdgcn_rsqf(fmaxf(nn, 1e-24f));
      float* d;
      d = sr + stt * 64 + kg * 8;
      *(f32x4*)d = (f32x4){fr[0], fr[1], fr[2], fr[3]}; *(f32x4*)(d + 4) = (f32x4){fr[4], fr[5], fr[6], fr[7]};
      d = sw + stt * 64 + kg * 8;
      *(f32x4*)d = (f32x4){__expf(fl[0]), __expf(fl[1]), __expf(fl[2]), __expf(fl[3])};
      *(f32x4*)(d + 4) = (f32x4){__expf(fl[4]), __expf(fl[5]), __expf(fl[6]), __expf(fl[7])};
      d = sk + stt * 64 + kg * 8;
      *(f32x4*)d = (f32x4){km[0], km[1], km[2], km[3]}; *(f32x4*)(d + 4) = (f32x4){km[4], km[5], km[6], km[7]};
      d = skk + stt * 64 + kg * 8;
      *(f32x4*)d = (f32x4){kkv[0] * inv, kkv[1] * inv, kkv[2] * inv, kkv[3] * inv};
      *(f32x4*)(d + 4) = (f32x4){kkv[4] * inv, kkv[5] * inv, kkv[6] * inv, kkv[7] * inv};
      d = sb + stt * 64 + kg * 8;
      *(f32x4*)d = (f32x4){kkv[0] * inv * fa[0], kkv[1] * inv * fa[1], kkv[2] * inv * fa[2], kkv[3] * inv * fa[3]};
      *(f32x4*)(d + 4) = (f32x4){kkv[4] * inv * fa[4], kkv[5] * inv * fa[5], kkv[6] * inv * fa[6], kkv[7] * inv * fa[7]};
      if ((kg >> 1) == rg) {
        d = sv + stt * 16 + (kg & 1) * 8;
        *(f32x4*)d = (f32x4){fv[0], fv[1], fv[2], fv[3]}; *(f32x4*)(d + 4) = (f32x4){fv[4], fv[5], fv[6], fv[7]};
      }
      if (rg == 0) {
        bn = allreduce8(bn);
        if (kg == 0) BON[(size_t)m * 8 + h] = bn;
      }
    }
    __syncthreads();
    if (t0 + TC < T) issue(t0 + TC);
    float ok0 = 0.f, ok1 = 0.f;
    const float* bs = (const float*)smem + kq * 4;
    f32x4 nkk = *(const f32x4*)(bs + 3 * TC * 64), nw = *(const f32x4*)(bs + TC * 64), nb = *(const f32x4*)(bs + 4 * TC * 64),
          nk = *(const f32x4*)(bs + 2 * TC * 64), nr = *(const f32x4*)bs;
    float nv = sv[row];
#pragma unroll
    for (int tt = 0; tt < TC; ++tt) {
      const f32x4 kk4 = nkk, w4 = nw, b4 = nb, k4 = nk, r4 = nr;
      const float v = nv;
      if (tt + 1 < TC) {
        const float* bn_ = bs + (tt + 1) * 64;
        nkk = *(const f32x4*)(bn_ + 3 * TC * 64); nw = *(const f32x4*)(bn_ + TC * 64); nb = *(const f32x4*)(bn_ + 4 * TC * 64);
        nk = *(const f32x4*)(bn_ + 2 * TC * 64); nr = *(const f32x4*)bn_;
        nv = sv[(tt + 1) * 16 + row];
      }
      float d = S[0] * kk4[0] + S[1] * kk4[1] + S[2] * kk4[2] + S[3] * kk4[3];
      d = allreduce16(d);
      const float sa = -d;
      S = S * w4 + sa * b4 + v * k4;
      float o = S[0] * r4[0] + S[1] * r4[1] + S[2] * r4[2] + S[3] * r4[3];
      o = allreduce16(o);
      if (tt < 16) ok0 = (kq == tt) ? o : ok0;
      else ok1 = (kq == tt - 16) ? o : ok1;
    }
    {
      bf16_t* so = (bf16_t*)(sv + TC * 16);
      so[kq * 16 + row] = f2bf(ok0);
      so[(16 + kq) * 16 + row] = f2bf(ok1);
      __syncthreads();
      if (tid < 64) {
        const int tk = tid >> 1, hf = tid & 1;
        *(u32x4*)(OA + (size_t)(mbase + t0 + tk) * 512 + h * 64 + rg * 16 + hf * 8) = *(const u32x4*)(so + tk * 16 + hf * 8);
      }
    }
  }
  float* sout = grp ? p->out + O_RW_S + ((((size_t)l * 32 + b) * 8 + h) * 64 + vrow) * 64 + kq * 4
                    : p->out + O_RW_P + ((((size_t)l * 4 + b) * 8 + h) * 64 + vrow) * 64 + kq * 4;
  *(f32x4*)sout = S;
}

template <int HD, int NKT, int MODE>
DI void attn16(const PP p, int l, const bf16_t* qrow, const float* qg, float qscale, const float* kf32, const bf16_t* kbf,
               const bf16_t* vt, int ldv, bf16_t* orow, int qi0, int chunk, float slope, float sink) {
  const int lane = tidx() & 63, l15 = lane & 15, quad = lane >> 4;
  constexpr int NKS = HD / 32;
  bf16x8 qf[NKS];
  {
    float qv[NKS][8];
    float ss = 0.f;
#pragma unroll
    for (int ks = 0; ks < NKS; ++ks) {
      u32x4 v = *(const u32x4*)(qrow + ks * 32 + quad * 8);
#pragma unroll
      for (int e = 0; e < 4; ++e) { qv[ks][2 * e] = lo16(v[e]); qv[ks][2 * e + 1] = hi16(v[e]); ss += qv[ks][2 * e] * qv[ks][2 * e] + qv[ks][2 * e + 1] * qv[ks][2 * e + 1]; }
    }
    ss += __shfl_xor(ss, 16);
    ss += __shfl_xor(ss, 32);
    const float rs = rsqrtf(ss * (1.f / HD) + RMS_EPS) * qscale;
#pragma unroll
    for (int ks = 0; ks < NKS; ++ks) {
      const float* g = qg + ks * 32 + quad * 8;
      u32x4 o;
#pragma unroll
      for (int e = 0; e < 4; ++e) o[e] = pack2(qv[ks][2 * e] * rs * g[2 * e], qv[ks][2 * e + 1] * rs * g[2 * e + 1]);
      qf[ks] = __builtin_bit_cast(bf16x8, o);
    }
  }
  f32x4 s[NKT];
  float mx = -INFINITY;
#pragma unroll
  for (int kt = 0; kt < NKT; ++kt) {
    f32x4 acc = (f32x4){0.f, 0.f, 0.f, 0.f};
    const int key = kt * 16 + l15;
#pragma unroll
    for (int ks = 0; ks < NKS; ++ks) {
      bf16x8 kfr;
      const int d0 = ks * 32 + quad * 8;
      if constexpr (MODE == 0 || MODE == 4) {
        const float* kp = kf32 + (size_t)key * 512 + d0;
        kfr = cvt8(*(const f32x4*)kp, *(const f32x4*)(kp + 4));
      } else if constexpr (MODE == 1) {
        int tokrel = (chunk - 2) * 64 + key;
        if (tokrel < 0) tokrel = 0;
        kfr = *(const bf16x8*)(kbf + (size_t)tokrel * MIXC + d0);
      } else if constexpr (MODE == 3) {
        kfr = *(const bf16x8*)((const unsigned char*)kbf + key * 128 + (((ks * 4 + quad) ^ (key & 7)) * 16));
      } else {
        if (kt < 8) {
          const float* kp = kf32 + (size_t)key * 128 + d0;
          kfr = cvt8(*(const f32x4*)kp, *(const f32x4*)(kp + 4));
        } else {
          kfr = *(const bf16x8*)(kbf + (size_t)(key - 128) * MIXC + d0);
        }
      }
      acc = MFMA16(kfr, qf[ks], acc);
    }
    if constexpr (MODE != 0 && MODE != 4) {
#pragma unroll
      for (int r = 0; r < 4; ++r) {
        const int kj = kt * 16 + quad * 4 + r;
        const float dist = fabsf((float)(128 + qi0 + l15 - kj));
        acc[r] = acc[r] - slope * dist;
        if ((MODE == 1 || MODE == 3) && (chunk - 2 + (kj >> 6)) < 0) acc[r] = -INFINITY;
      }
    }
    s[kt] = acc;
    mx = fmaxf(mx, fmaxf(fmaxf(acc[0], acc[1]), fmaxf(acc[2], acc[3])));
    __builtin_amdgcn_sched_barrier(0);
  }
  mx = fmaxf(mx, __shfl_xor(mx, 16));
  mx = fmaxf(mx, __shfl_xor(mx, 32));
  if constexpr (MODE != 0 && MODE != 4) mx = fmaxf(mx, sink);
  float sum = 0.f;
#pragma unroll
  for (int kt = 0; kt < NKT; ++kt)
#pragma unroll
    for (int r = 0; r < 4; ++r) { const float e = __expf(s[kt][r] - mx); s[kt][r] = e; sum += e; }
  sum += __shfl_xor(sum, 16);
  sum += __shfl_xor(sum, 32);
  if constexpr (MODE != 0 && MODE != 4) sum += __expf(sink - mx);
  const float inv = 1.f / sum;
  f32x4 o[HD / 16];
#pragma unroll
  for (int dt = 0; dt < HD / 16; ++dt) o[dt] = (f32x4){0.f, 0.f, 0.f, 0.f};
#pragma unroll
  for (int kb = 0; kb < NKT / 2; ++kb) {
    u32x4 pp;
    pp[0] = pack2(s[2 * kb][0], s[2 * kb][1]); pp[1] = pack2(s[2 * kb][2], s[2 * kb][3]);
    pp[2] = pack2(s[2 * kb + 1][0], s[2 * kb + 1][1]); pp[3] = pack2(s[2 * kb + 1][2], s[2 * kb + 1][3]);
    const bf16x8 pf = __builtin_bit_cast(bf16x8, pp);
#pragma unroll
    for (int dt = 0; dt < HD / 16; ++dt) {
      u32x2 v0, v1;
      if constexpr (MODE == 4) {
        const unsigned char* vr = (const unsigned char*)vt + (dt * 16 + l15) * 512 + (quad & 1) * 8;
        const int c0 = kb * 4 + (quad >> 1);
        v0 = *(const u32x2*)(vr + ((c0 ^ l15) * 16));
        v1 = *(const u32x2*)(vr + (((c0 + 2) ^ l15) * 16));
      } else {
        const bf16_t* vp = vt + (size_t)(dt * 16 + l15) * ldv + kb * 32 + quad * 4;
        v0 = *(const u32x2*)vp; v1 = *(const u32x2*)(vp + 16);
      }
      u32x4 vv; vv[0] = v0[0]; vv[1] = v0[1]; vv[2] = v1[0]; vv[3] = v1[1];
      o[dt] = MFMA16(__builtin_bit_cast(bf16x8, vv), pf, o[dt]);
    }
    __builtin_amdgcn_sched_barrier(0);
  }
#pragma unroll
  for (int dt = 0; dt < HD / 16; ++dt) {
    u32x2 ov; ov[0] = pack2(o[dt][0] * inv, o[dt][1] * inv); ov[1] = pack2(o[dt][2] * inv, o[dt][3] * inv);
    *(u32x2*)(orow + dt * 16 + quad * 4) = ov;
  }
}

constexpr int Q_REC_S = 1024, Q_SWA = 576, Q_MEM = 1152, Q_TOTAL = Q_REC_S + Q_SWA + Q_MEM;
DI void phase_mixers(const PP p, int l, unsigned char* smem, int slot) {
  const int tid = tidx(), w = tid >> 6, lane = tid & 63, l15 = lane & 15;
  const bf16_t* P = (const bf16_t*)(p->ws + WS_P);
  unsigned* ctr = (unsigned*)(p->ws + WS_CTR) + slot * 16;
  int* sitem = (int*)(smem + 65536 + 16);
  if (blockIdx.x < 128) rwkv_unit(p, l, 0, blockIdx.x >> 5, (blockIdx.x >> 2) & 7, blockIdx.x & 3, smem);
  const bool quiet_ = (gridDim.x == 512) && (blockIdx.x >= 256) && (blockIdx.x < 384);
  for (; !quiet_;) {
    __syncthreads();
    if (tid == 0) *sitem = (int)atomicAdd(ctr, 1u);
    __syncthreads();
    int item = *sitem;
    if (item >= Q_TOTAL) break;
    item = __builtin_amdgcn_readfirstlane(item);
    asm volatile("" : "+s"(item));
    if (item < Q_REC_S) {
      rwkv_unit(p, l, 1, item >> 5, (item >> 2) & 7, item & 3, smem);
    } else if (item < Q_REC_S + Q_SWA) {
      const int u = item - Q_REC_S;
      const float* qg = p->in[23] + l * 64;
      if (u < 512) {
        const int kvh = u & 1, chunk = (u >> 1) & 63, b = u >> 7, h = kvh * 4 + w;
        const float slope = exp2f(-(float)(h + 1)), sink = p->in[25][l * 8 + h];
        const bf16_t* kb = P + (size_t)(b * 4096) * MIXC + C_SK + kvh * 64;
        const bf16_t* vt = (const bf16_t*)(p->ws + WS_VSP) + (size_t)(b * 2 + kvh) * 64 * VSP_LD + chunk * 64;
        unsigned char* Kl = smem;
        bf16_t* Vl = (bf16_t*)(smem + 24576);
#pragma unroll 2
        for (int k = 0; k < 6; ++k) {
          const int idx = tid + k * 256, r = idx >> 3, c = idx & 7;
          int tokrel = (chunk - 2) * 64 + r;
          if (tokrel < 0) tokrel = 0;
          *(u32x4*)(Kl + r * 128 + ((c ^ (r & 7)) * 16)) = *(const u32x4*)(kb + (size_t)tokrel * MIXC + c * 8);
          const int d = idx / 24, ch = idx % 24;
          *(u32x4*)(Vl + d * 200 + ch * 8) = *(const u32x4*)(vt + (size_t)d * VSP_LD + ch * 8);
        }
        __syncthreads();
#pragma unroll 1
        for (int qs = 0; qs < 4; ++qs) {
          const int m = b * 4096 + chunk * 64 + qs * 16 + l15;
          attn16<64, 12, 3>(p, l, P + (size_t)m * MIXC + C_Q + h * 64, qg, 0.125f, nullptr, (const bf16_t*)Kl, Vl, 200,
                            (bf16_t*)(p->ws + WS_OB) + (size_t)m * 512 + h * 64, qs * 16, chunk, slope, sink);
        }
      } else {
        const int v = u - 512, kvh = v & 1, b = v >> 1, h = kvh * 4 + w;
        const float slope = exp2f(-(float)(h + 1)), sink = p->in[25][l * 8 + h];
        const float* kc = p->in[2] + ((size_t)l * 32 + b) * 128 * 128 + kvh * 64;
        const bf16_t* kb = P + (size_t)(TP + b * 64) * MIXC + C_SK + kvh * 64;
        const bf16_t* vt = (const bf16_t*)(p->ws + WS_VSS) + (size_t)(b * 2 + kvh) * 64 * 192;
        unsigned char* Kl = smem;
        bf16_t* Vl = (bf16_t*)(smem + 24576);
#pragma unroll 2
        for (int k = 0; k < 6; ++k) {
          const int idx = tid + k * 256, r = idx >> 3, c = idx & 7;
          u32x4 kv;
          if (r < 128) { const float* kp = kc + (size_t)r * 128 + c * 8; kv = __builtin_bit_cast(u32x4, cvt8(*(const f32x4*)kp, *(const f32x4*)(kp + 4))); }
          else kv = *(const u32x4*)(kb + (size_t)(r - 128) * MIXC + c * 8);
          *(u32x4*)(Kl + r * 128 + ((c ^ (r & 7)) * 16)) = kv;
          const int d = idx / 24, ch = idx % 24;
          *(u32x4*)(Vl + d * 200 + ch * 8) = *(const u32x4*)(vt + (size_t)d * 192 + ch * 8);
        }
        __syncthreads();
#pragma unroll 1
        for (int qs = 0; qs < 4; ++qs) {
          const int m = TP + b * 64 + qs * 16 + l15;
          attn16<64, 12, 3>(p, l, P + (size_t)m * MIXC + C_Q + h * 64, qg, 0.125f, nullptr, (const bf16_t*)Kl, Vl, 200,
                            (bf16_t*)(p->ws + WS_OB) + (size_t)m * 512 + h * 64, qs * 16, 2, slope, sink);
        }
      }
    } else {
      const int u = item - Q_REC_S - Q_SWA, h = u & 3, tile = u >> 2;
      const int m = tile * 64 + w * 16 + l15;
      const int bb = m < TP ? (m >> 12) : 4 + ((m - TP) >> 6);
      const float* kf = (bb < 4 ? p->out + O_MK_P + ((size_t)l * 4 + bb) * 256 * 512 : p->in[4] + ((size_t)l * 32 + (bb - 4)) * 256 * 512) + h * 128;
      const bf16_t* vt = (const bf16_t*)(p->ws + WS_VM) + (size_t)(bb * 4 + h) * 128 * 256;
#pragma unroll 4
      for (int k = 0; k < 16; ++k) {
        const int idx = tid + k * 256, d = idx >> 5, ch = idx & 31;
        *(u32x4*)(smem + d * 512 + ((ch ^ (d & 15)) * 16)) = *(const u32x4*)(vt + (size_t)d * 256 + ch * 8);
      }
      __syncthreads();
      attn16<128, 16, 4>(p, l, P + (size_t)m * MIXC + C_QM + h * 128, p->in[28] + l * 128, 0.08838834764831845f, kf, nullptr, (const bf16_t*)smem, 256,
                         (bf16_t*)(p->ws + WS_OM) + (size_t)m * 512 + h * 128, 0, 0, 0.f, 0.f);
    }
  }
  if ((blockIdx.x & 255) >= 128) {
    for (;;) {
      __syncthreads();
      if (tid == 0) *sitem = (int)atomicAdd(ctr + 8, 1u);
      __syncthreads();
      int u = *sitem;
      if (u >= 2304) break;
      u = __builtin_amdgcn_readfirstlane(u);
      gates_tile(p, l, (u >> 4) * 128, (u & 15) * 128, smem);
    }
  }
}

DI void phase_post(const PP p, int l, unsigned char* smem) {
  const bf16_t* P = (const bf16_t*)(p->ws + WS_P);
  const bf16_t* LIN = (const bf16_t*)(p->ws + WS_LIN);
  bf16_t* OA = (bf16_t*)(p->ws + WS_OA);
  const float* BON = (const float*)(p->ws + WS_BON);
  const float* lng = p->in[21] + l * 512;
  const float* lnb = p->in[22] + l * 512;
  const float* muv = p->in[12] + l * RC + C_V;
  for (int t = blockIdx.x; t < 144 * 4; t += gridDim.x) {
    const int m0 = (t >> 2) * 128, n0 = (t & 3) * 128;
    f32x4 acc[4][4];
    zero_acc<4, 4>(acc);
    gemm_acc<4, 4>(acc, LIN + (size_t)m0 * 256 + 128, 256, (const bf16_t*)(p->ws + WS_WG2) + (size_t)n0 * 128, 128, 128, smem);
    EPI_IDX(4, 4)
    __syncthreads();
    const int hh = (n0 + wn_ * 64) >> 6;
#pragma unroll
    for (int i = 0; i < 4; ++i) {
      const int m = mb_ + i * 16, tt = tok_t(m);
      float ov[4][4];
      float sm = 0.f;
#pragma unroll
      for (int j = 0; j < 4; ++j) {
        u32x2 v = *(const u32x2*)(OA + (size_t)m * 512 + nb_ + j * 16);
        ov[j][0] = lo16(v[0]); ov[j][1] = hi16(v[0]); ov[j][2] = lo16(v[1]); ov[j][3] = hi16(v[1]);
        sm += ov[j][0] + ov[j][1] + ov[j][2] + ov[j][3];
      }
      sm += __shfl_xor(sm, 16);
      sm += __shfl_xor(sm, 32);
      const float mean = sm * (1.f / 64.f);
      float vs = 0.f;
#pragma unroll
      for (int j = 0; j < 4; ++j)
#pragma unroll
        for (int r = 0; r < 4; ++r) { const float d = ov[j][r] - mean; vs += d * d; }
      vs += __shfl_xor(vs, 16);
      vs += __shfl_xor(vs, 32);
      const float rstd = rsqrtf(vs * (1.f / 64.f) + GN_EPS);
      const float bon = BON[(size_t)m * 8 + hh];
#pragma unroll
      for (int j = 0; j < 4; ++j) {
        const int n = nb_ + j * 16;
        u32x2 cv = *(const u32x2*)(P + (size_t)m * MIXC + C_V + n);
        float pv[4] = {lo16(cv[0]), hi16(cv[0]), lo16(cv[1]), hi16(cv[1])};
        float qv[4];
        if (tt > 0) {
          u32x2 pvv = *(const u32x2*)(P + (size_t)(m - 1) * MIXC + C_V + n);
          qv[0] = lo16(pvv[0]); qv[1] = hi16(pvv[0]); qv[2] = lo16(pvv[1]); qv[3] = hi16(pvv[1]);
        } else {
#pragma unroll
          for (int r = 0; r < 4; ++r) qv[r] = shift_in(p, l, m, C_V + n + r);
        }
        float res[4];
#pragma unroll
        for (int r = 0; r < 4; ++r) {
          const float vmix = pv[r] + (qv[r] - pv[r]) * muv[n + r];
          res[r] = ((ov[j][r] - mean) * rstd * lng[n + r] + lnb[n + r] + bon * vmix) * acc[i][j][r];
        }
        { u32x2 o_; o_[0] = pack2(res[0], res[1]); o_[1] = pack2(res[2], res[3]);
          *(u32x2*)(smem + (wm_ * 64 + i * 16 + l15_) * 272 + (wn_ * 64 + j * 16 + quad_ * 4) * 2) = o_; }
      }
    }
    tile_flush<4>(OA, 512, m0, n0, smem);
  }
}

DI void phase_gates(const PP p, int l, unsigned char* smem) {
  const int nt = 8, nb = 16;
  for (int t = blockIdx.x; t < 144 * nt; t += gridDim.x) gates_tile(p, l, (t / nt) * 128, (nb + t % nt) * 128, smem);
}
DI void phase_merge(const PP p, int l, unsigned char* smem) {
  const bf16_t* G = (const bf16_t*)(p->ws + WS_P);
  bf16_t* MG = (bf16_t*)(p->ws + WS_LD);
  for (int t = blockIdx.x; t < 144 * 16; t += gridDim.x) {
    const int m0 = (t >> 4) * 128, n0 = (t & 15) * 64;
    f32x4 mg[4][2];
    zero_acc<4, 2>(mg);
    EPI_IDX(4, 2)
#pragma unroll 1
    for (int br = 0; br < 3; ++br) {
      f32x4 ab[4][2];
      zero_acc<4, 2>(ab);
      gemm_acc<4, 2>(ab, (const bf16_t*)(p->ws + WS_OA + (size_t)br * 18874368) + (size_t)m0 * 512, 512,
                     (const bf16_t*)(p->ws + WS_WBR + (size_t)br * 1048576) + (size_t)n0 * 512, 512, 512, smem);
#pragma unroll
      for (int i = 0; i < 4; ++i)
#pragma unroll
        for (int j = 0; j < 2; ++j) {
          const bf16_t* gp = (br < 2) ? (const bf16_t*)p->out + (size_t)(mb_ + i * 16) * 2048 + br * 1024 + nb_ + j * 16
                                                : G + (size_t)(mb_ + i * 16) * MIXC + br * 1024 + nb_ + j * 16;
          const u32x2 g = *(const u32x2*)gp;
          mg[i][j][0] += lo16(g[0]) * ab[i][j][0];
          mg[i][j][1] += hi16(g[0]) * ab[i][j][1];
          mg[i][j][2] += lo16(g[1]) * ab[i][j][2];
          mg[i][j][3] += hi16(g[1]) * ab[i][j][3];
        }
      __builtin_amdgcn_sched_barrier(0);
    }
    u32x2 ov[4][2];
#pragma unroll
    for (int i = 0; i < 4; ++i)
#pragma unroll
      for (int j = 0; j < 2; ++j) {
        ov[i][j][0] = pack2(mg[i][j][0], mg[i][j][1]); ov[i][j][1] = pack2(mg[i][j][2], mg[i][j][3]);
      }
    store_tile<2>(ov, MG, 1024, m0, n0, smem);
  }
}

DI f32x4 resid4(const PP p, int l, int m, int n) {
  if (l == 0) return *(const f32x4*)(xrow(p, 0, m) + n);
  const u32x2 v = *(const u32x2*)((const bf16_t*)(p->ws + WS_XB) + (size_t)m * 1024 + n);
  return (f32x4){lo16(v[0]), hi16(v[0]), lo16(v[1]), hi16(v[1])};
}
DI void phase_out(const PP p, int l, unsigned char* smem) {
  const bf16_t* MG = (const bf16_t*)(p->ws + WS_LD);
  for (int t = blockIdx.x; t < 1024; t += gridDim.x) {
    const int m0 = (t >> 3) * 128, n0 = (t & 7) * 128;
    f32x4 acc[4][4];
    zero_acc<4, 4>(acc);
    gemm_acc<4, 4>(acc, MG + (size_t)m0 * 1024, 1024, (const bf16_t*)(p->ws + WS_WOUT) + (size_t)n0 * 1024, 1024, 1024, smem);
    EPI_IDX(4, 4)
#pragma unroll
    for (int i = 0; i < 4; ++i) {
      const int m = mb_ + i * 16;
#pragma unroll
      for (int j = 0; j < 4; ++j) {
        const int n = nb_ + j * 16;
        f32x4 xv = resid4(p, l, m, n);
        *(f32x4*)(p->out + (size_t)m * DM + n) = xv + acc[i][j];
      }
    }
  }
  for (int hb = blockIdx.x; hb < 256; hb += gridDim.x) {
    const int t = 1024 + (hb >> 1), m0 = (t >> 3) * 128, n0 = (t & 7) * 128 + (hb & 1) * 64;
    f32x4 acc[4][2];
    zero_acc<4, 2>(acc);
    gemm_acc<4, 2>(acc, MG + (size_t)m0 * 1024, 1024, (const bf16_t*)(p->ws + WS_WOUT) + (size_t)n0 * 1024, 1024, 1024, smem);
    EPI_IDX(4, 2)
#pragma unroll
    for (int i = 0; i < 4; ++i) {
      const int m = mb_ + i * 16;
#pragma unroll
      for (int j = 0; j < 2; ++j) {
        const int n = nb_ + j * 16;
        f32x4 xv = resid4(p, l, m, n);
        *(f32x4*)(p->out + (size_t)m * DM + n) = xv + acc[i][j];
      }
    }
  }
}

DI void phase_up_a(const PP p, int l, unsigned char* smem) {
  const float* rs2 = (const float*)(p->ws + WS_RS2);
  bf16_t* AIN = (bf16_t*)(p->ws + WS_P);
  for (int t = blockIdx.x; t < 144 * 22; t += gridDim.x) {
    const int m0 = (t / 22) * 128, n0 = (t % 22) * 128;
    f32x4 acc[4][4];
    zero_acc<4, 4>(acc);
    gemm_acc<4, 4>(acc, (const bf16_t*)(p->ws + WS_XB) + (size_t)m0 * 1024, 1024, (const bf16_t*)(p->ws + WS_WUP) + (size_t)n0 * 1024, 1024, 1024, smem);
    EPI_IDX(4, 4)
    u32x2 ov[4][4];
#pragma unroll
    for (int i = 0; i < 4; ++i) {
      const int m = mb_ + i * 16, tt = tok_t(m), T = m < TP ? 4096 : 64;
      const float rs = rs2[m];
#pragma unroll
      for (int j = 0; j < 4; ++j) {
        const int n = nb_ + j * 16;
        f32x4 v = acc[i][j] * rs;
        u32x2 o; o[0] = pack2(v[0], v[1]); o[1] = pack2(v[2], v[3]);
        ov[i][j] = o;
        if (tt >= T - 2) {
          float* co = m < TP ? p->out + O_CV_P + (((size_t)l * 4 + (m >> 12)) * 2 + (tt - (T - 2))) * DFF + n
                             : p->out + O_CV_S + (((size_t)l * 32 + ((m - TP) >> 6)) * 2 + (tt - (T - 2))) * DFF + n;
          *(f32x4*)co = v;
        }
      }
    }
    store_tile<4>(ov, AIN, DFF, m0, n0, smem);
  }
}
DI float gelu_tanh(float x) {
  const float u2 = 1.5957691216057308f * (x + 0.044715f * x * x * x);
  return x * __builtin_amdgcn_rcpf(1.f + __expf(-u2));
}
DI void phase_up_u(const PP p, int l, unsigned char* smem) {
  const float* rs2 = (const float*)(p->ws + WS_RS2);
  const bf16_t* AIN = (const bf16_t*)(p->ws + WS_P);
  bf16_t* ACT = (bf16_t*)(p->ws + WS_R);
  const float* cw = p->in[34] + (size_t)l * 3 * DFF;
  const float* cb = p->in[35] + (size_t)l * DFF;
  for (int t = blockIdx.x; t < 144 * 22; t += gridDim.x) {
    const int m0 = (t / 22) * 128, n0 = (t % 22) * 128;
    f32x4 acc[4][4];
    zero_acc<4, 4>(acc);
    gemm_acc<4, 4>(acc, (const bf16_t*)(p->ws + WS_XB) + (size_t)m0 * 1024, 1024, (const bf16_t*)(p->ws + WS_WUP) + (size_t)(DFF + n0) * 1024, 1024, 1024, smem);
    EPI_IDX(4, 4)
    __syncthreads();
#pragma unroll 3
    for (int k = 0; k < 9; ++k) {
      const int idx = tid_ + k * 256, rr = idx >> 4, ch = idx & 15, mr = m0 - 2 + rr;
      if (rr < 130 && mr >= 0) *(u32x4*)(smem + rr * 272 + ch * 16) = *(const u32x4*)(AIN + (size_t)mr * DFF + n0 + ch * 8);
    }
    __syncthreads();
    u32x2 ov[4][4];
#pragma unroll
    for (int i = 0; i < 4; ++i) {
      const int m = mb_ + i * 16, tt = tok_t(m);
      const float rs = rs2[m];
#pragma unroll
      for (int j = 0; j < 4; ++j) {
        const int n = nb_ + j * 16;
        f32x4 c = *(const f32x4*)(cb + n);
#pragma unroll
        for (int jj = 0; jj < 3; ++jj) {
          const int ts = tt - 2 + jj;
          f32x4 av;
          if (ts >= 0) {
            u32x2 v = *(const u32x2*)(smem + (m - m0 + jj) * 272 + (n - n0) * 2);
            av = (f32x4){lo16(v[0]), hi16(v[0]), lo16(v[1]), hi16(v[1])};
          } else if (m >= TP) {
            av = *(const f32x4*)(p->in[8] + (((size_t)l * 32 + ((m - TP) >> 6)) * 2 + (ts + 2)) * DFF + n);
          } else {
            av = (f32x4){0.f, 0.f, 0.f, 0.f};
          }
          c += av * *(const f32x4*)(cw + jj * DFF + n);
        }
        f32x4 u = acc[i][j] * rs;
        u32x2 o; o[0] = pack2(gelu_tanh(c[0]) * u[0], gelu_tanh(c[1]) * u[1]); o[1] = pack2(gelu_tanh(c[2]) * u[2], gelu_tanh(c[3]) * u[3]);
        ov[i][j] = o;
      }
    }
    store_tile<4>(ov, ACT, DFF, m0, n0, smem);
  }
}
DI void phase_down(const PP p, int l, unsigned char* smem) {
  const bf16_t* ACT = (const bf16_t*)(p->ws + WS_R);
  for (int t = blockIdx.x; t < 1024; t += gridDim.x) {
    const int m0 = (t >> 3) * 128, n0 = (t & 7) * 128;
    f32x4 acc[4][4];
    zero_acc<4, 4>(acc);
    gemm_acc<4, 4>(acc, ACT + (size_t)m0 * DFF, DFF, (const bf16_t*)(p->ws + WS_WDN) + (size_t)n0 * DFF, DFF, DFF, smem);
    EPI_IDX(4, 4)
#pragma unroll
    for (int i = 0; i < 4; ++i) {
      const int m = mb_ + i * 16;
#pragma unroll
      for (int j = 0; j < 4; ++j) {
        float* y = p->out + (size_t)m * DM + nb_ + j * 16;
        *(f32x4*)y = *(const f32x4*)y + acc[i][j];
      }
    }
  }
  for (int hb = blockIdx.x; hb < 256; hb += gridDim.x) {
    const int t = 1024 + (hb >> 1), m0 = (t >> 3) * 128, n0 = (t & 7) * 128 + (hb & 1) * 64;
    f32x4 acc[4][2];
    zero_acc<4, 2>(acc);
    gemm_acc<4, 2>(acc, ACT + (size_t)m0 * DFF, DFF, (const bf16_t*)(p->ws + WS_WDN) + (size_t)n0 * DFF, DFF, DFF, smem);
    EPI_IDX(4, 2)
#pragma unroll
    for (int i = 0; i < 4; ++i) {
      const int m = mb_ + i * 16;
#pragma unroll
      for (int j = 0; j < 2; ++j) {
        float* y = p->out + (size_t)m * DM + nb_ + j * 16;
        *(f32x4*)y = *(const f32x4*)y + acc[i][j];
      }
    }
  }
}


#define XB_TMO      128
#define XB_XCNT(j)  (256  + 64 * (j))
#define XB_XSUB(j)  (1280 + 64 * (j))
#define XB_XGEN(j)  (2304 + 64 * (j))
#define XB_TOP      3328
#define XB_TOPGEN   3392
#define XCD_BAR_WORDS 3456
#define XB_SPIN_CAP (1u << 18)
#define LAS __attribute__((address_space(3)))
DI unsigned xb_ld(unsigned* p) { return __hip_atomic_load(p, __ATOMIC_RELAXED, __HIP_MEMORY_SCOPE_AGENT); }
DI unsigned xb_add(unsigned* p, unsigned v) { return __hip_atomic_fetch_add(p, v, __ATOMIC_RELAXED, __HIP_MEMORY_SCOPE_AGENT); }
DI unsigned xb_xcc_id() { return (unsigned)__builtin_amdgcn_s_getreg((3 << 11) | 20) & 0xFu; }
#define XB_SPIN(cond, bar) do { unsigned _sp = 0; while (cond) { __builtin_amdgcn_s_sleep(1); \
    if ((++_sp & 255u) == 0u) { if (xb_ld(&(bar)[XB_TMO])) break; if (_sp > XB_SPIN_CAP) { atomicAdd(&(bar)[XB_TMO], 1u); break; } } } } while (0)
struct XcdBarrier { unsigned* bar; unsigned x; volatile LAS unsigned* st; };
DI XcdBarrier xcd_barrier_post(unsigned* bar, volatile LAS unsigned* st) {
  XcdBarrier b; b.bar = bar; b.x = xb_xcc_id(); b.st = st;
  if (threadIdx.x == 0) (void)xb_add(&bar[XB_XCNT(b.x)], 1u);
  return b;
}
DI void xcd_barrier_complete(unsigned* bar, unsigned x, unsigned& nloc, unsigned& nx) {
  const unsigned G = gridDim.x * gridDim.y * gridDim.z;
  unsigned sum, cnt, mine, sp = 0u;
  for (;;) {
    sum = 0u; cnt = 0u; mine = 0u;
#pragma unroll
    for (unsigned j = 0; j < 16; ++j) { const unsigned c = xb_ld(&bar[XB_XCNT(j)]); sum += c; cnt += (c > 0u) ? 1u : 0u; mine = (j == x) ? c : mine; }
    if (sum == G) break;
    __builtin_amdgcn_s_sleep(1);
    if ((++sp & 255u) == 0u) { if (xb_ld(&bar[XB_TMO])) break; if (sp > XB_SPIN_CAP) { atomicAdd(&bar[XB_TMO], 1u); break; } }
  }
  nloc = mine > 0u ? mine : 1u; nx = cnt > 0u ? cnt : 1u;
}
DI void xcd_barrier(const XcdBarrier& b) {
  asm volatile("s_waitcnt vmcnt(0)" ::: "memory");
  __syncthreads();
  if (threadIdx.x == 0) {
    unsigned* bar = b.bar;
    __builtin_amdgcn_s_waitcnt(0);
    unsigned nloc = b.st[0], nx = b.st[1];
    if (nloc == 0u) { xcd_barrier_complete(bar, b.x, nloc, nx); b.st[0] = nloc; b.st[1] = nx; }
    const unsigned old = xb_add(&bar[XB_XSUB(b.x)], 1u);
    const unsigned gen = old / nloc;
    if (old + 1u == (gen + 1u) * nloc) {
      __builtin_amdgcn_fence(__ATOMIC_RELEASE, "agent");
      asm volatile("s_waitcnt vmcnt(0)" ::: "memory");
      const unsigned og = xb_add(&bar[XB_TOP], 1u);
      const unsigned tg = og / nx;
      if (og + 1u == (tg + 1u) * nx) xb_add(&bar[XB_TOPGEN], 1u);
      else XB_SPIN(xb_ld(&bar[XB_TOPGEN]) == tg, bar);
      __builtin_amdgcn_fence(__ATOMIC_ACQUIRE, "agent");
      xb_add(&bar[XB_XGEN(b.x)], 1u);
      asm volatile("s_waitcnt vmcnt(0)" ::: "memory");
    } else {
      XB_SPIN(xb_ld(&bar[XB_XGEN(b.x)]) == gen, bar);
      __builtin_amdgcn_fence(__ATOMIC_ACQUIRE, "agent");
      asm volatile("s_waitcnt vmcnt(0)" ::: "memory");
    }
  }
  __syncthreads();
}

__global__ void __launch_bounds__(256, 2) mega(Params p_arg) {
  __shared__ __attribute__((aligned(16))) unsigned char smem[65536 + 64];
  cg::grid_group grid = cg::this_grid();
  __shared__ uint4 xb_words;
  if (threadIdx.x == 0) xb_words = make_uint4(0u, 0u, 0u, 0u);
  __syncthreads();
  const XcdBarrier xb = xcd_barrier_post((unsigned*)(p_arg.ws + WS_BAR), (volatile LAS unsigned*)&xb_words);
  if (p_arg.out == nullptr) grid.sync();
#pragma unroll 1
  for (int ph = 0; ph < 26; ++ph) {
    int l = ph >= 13 ? 1 : 0;
    const __attribute__((address_space(4))) Params* kp = (const __attribute__((address_space(4))) Params*)__builtin_amdgcn_kernarg_segment_ptr();
    l = __builtin_amdgcn_readfirstlane(l);
    asm volatile("" : "+s"(kp));
    asm volatile("" : "+s"(l));
    const PP p = kp;
    switch (ph - l * 13) {
      case 0: phase_convert(p, l, smem); break;
      case 1: phase_gemm_in(p, l, smem); break;
      case 2: phase_prep(p, l, 0); break;
      case 3: phase_lora(p, l, smem); phase_prep(p, l, 1); break;
      case 4: phase_mixers(p, l, smem, ph); break;
      case 5: phase_post(p, l, smem); break;
      case 6: phase_gates(p, l, smem); break;
      case 7: phase_merge(p, l, smem); break;
      case 8: phase_out(p, l, smem); break;
      case 9: phase_stats2(p); break;
      case 10: phase_up_a(p, l, smem); break;
      case 11: phase_up_u(p, l, smem); break;
      default: phase_down(p, l, smem); break;
    }
    if (ph + 1 < 26) xcd_barrier(xb);
  }
}

extern "C" void kernel_launch(void* const* d_in, const int* in_sizes, int n_in, void* d_out, int out_size, void* d_ws, size_t ws_size,
                              hipStream_t stream) {
  static int grid_blocks = 0;
  if (!grid_blocks) {
    int dev = 0, cus = 0, per_cu = 0;
    (void)hipGetDevice(&dev);
    (void)hipDeviceGetAttribute(&cus, hipDeviceAttributeMultiprocessorCount, dev);
    (void)hipOccupancyMaxActiveBlocksPerMultiprocessor(&per_cu, mega, 256, 0);
    if (per_cu > 2) per_cu = 2;
    if (per_cu < 1) per_cu = 1;
    grid_blocks = cus * per_cu;
  }
  if (ws_size < WS_END) fprintf(stderr, "workspace too small: %zu < %zu\n", ws_size, (size_t)WS_END);
  Params p{};
  for (int i = 0; i < 37; ++i) p.in[i] = (const float*)d_in[i];
  p.out = (float*)d_out;
  p.ws = (unsigned char*)d_ws;
  (void)hipMemsetAsync(d_ws, 0, 4096 + 16384, stream);
  void* args[] = {&p};
  hipError_t e = hipLaunchCooperativeKernel((void*)mega, dim3(grid_blocks), dim3(256), args, 0, stream);
  if (e != hipSuccess) fprintf(stderr, "coop launch failed: %s\n", hipGetErrorString(e));
}
```
